# Optimizing an MI355X kernel written in HIP

```python
import math
import jax, jax.numpy as jnp
from jax import lax
import numpy as np

D_MODEL = 1024
BATCH = 2
SEQ = 8192
DEPTH = 1

CHUNK = 64
Q_BLOCK = 128
MEM_LEN = 256
EPS = 1e-6
SSM_WIDTH = D_MODEL
SSM_GROUP = 16
SSM_GROUPS = SSM_WIDTH // SSM_GROUP
SSM_STATE = 64
DT_MIN = 1e-3
DT_MAX = 1e-1
DA_HEADS = 8
DA_HEAD_DIM = D_MODEL // (2 * DA_HEADS)
DA_V_DIM = 2 * DA_HEAD_DIM
DA_QK_WIDTH = DA_HEADS * 2 * DA_HEAD_DIM
DA_WIDTH = DA_HEADS * DA_V_DIM
ROPE_THETA = 10000.0
XA_HEADS = 4
XA_HEAD_DIM = D_MODEL // XA_HEADS
D_FF = 4 * D_MODEL
COL_SSM = SSM_WIDTH
COL_Q = COL_SSM + DA_QK_WIDTH
COL_K = COL_Q + DA_QK_WIDTH
COL_V = COL_K + DA_WIDTH
IN_COLS = COL_V + 2 * D_MODEL

kernel_name = "hybrid_s5_diffattn_gated_stream_encoder"

F32 = jnp.float32


def rms_norm(x, g):
    xf = x.astype(F32)
    y = xf * lax.rsqrt(jnp.mean(xf * xf, axis=-1, keepdims=True) + EPS)
    return (y * g.astype(F32)).astype(x.dtype)


def rope_tables(seqlen, dim):
    inv = ROPE_THETA ** (-jnp.arange(0, dim, 2, dtype=F32) / dim)
    ang = jnp.arange(seqlen, dtype=F32)[:, None] * inv[None, :]
    return jnp.cos(ang), jnp.sin(ang)


def apply_rope(t, cos, sin):
    half = t.shape[-1] // 2
    c = cos[:, None, None, :]
    s = sin[:, None, None, :]
    t1, t2 = t[..., :half], t[..., half:]
    return jnp.concatenate([t1 * c - t2 * s, t2 * c + t1 * s], axis=-1)


def s5_branch(u, lam_re, lam_im, log_dt, b_re, b_im, c_re, c_im, d_skip):
    bsz, seqlen, _ = u.shape
    ug = u.astype(F32).reshape(bsz, seqlen, SSM_GROUPS, SSM_GROUP).astype(jnp.complex64)
    lam = lax.complex(lam_re.astype(F32), lam_im.astype(F32))
    dt = jnp.exp(log_dt.astype(F32))[:, None]
    lam_bar = jnp.exp(lam * dt)
    b = lax.complex(b_re.astype(F32), b_im.astype(F32))
    c = lax.complex(c_re.astype(F32), c_im.astype(F32))
    b_bar = ((lam_bar - 1.0) / lam)[..., None] * b
    bu = jnp.einsum('gph,blgh->lbgp', b_bar, ug)
    a = jnp.broadcast_to(lam_bar, (seqlen,) + lam_bar.shape)

    def combine(e_i, e_j):
        a_i, s_i = e_i
        a_j, s_j = e_j
        return a_j * a_i, a_j[:, None] * s_i + s_j

    _, states = lax.associative_scan(combine, (a, bu), axis=0)
    y = jnp.einsum('ghp,lbgp->blgh', c, states).real
    y = y.reshape(bsz, seqlen, SSM_WIDTH) + d_skip.astype(F32) * u.astype(F32)
    return y.astype(u.dtype)


def diff_attention(q, k, v, lq1, lk1, lq2, lk2, head_norm, lam_init):
    bsz, seqlen, _ = q.shape
    nb = seqlen // Q_BLOCK
    cos, sin = rope_tables(seqlen, DA_HEAD_DIM)
    q = apply_rope(q.astype(F32).reshape(bsz, seqlen, DA_HEADS, 2, DA_HEAD_DIM), cos, sin)
    k = apply_rope(k.astype(F32).reshape(bsz, seqlen, DA_HEADS, 2, DA_HEAD_DIM), cos, sin)
    q = jnp.transpose(q, (0, 2, 3, 1, 4))
    k = jnp.transpose(k, (0, 2, 3, 1, 4))
    vv = jnp.transpose(v.astype(F32).reshape(bsz, seqlen, DA_HEADS, DA_V_DIM), (0, 2, 1, 3))
    qblocks = jnp.moveaxis(q.reshape(bsz, DA_HEADS, 2, nb, Q_BLOCK, DA_HEAD_DIM), 3, 0)
    lam = (jnp.exp(jnp.sum(lq1.astype(F32) * lk1.astype(F32)))
           - jnp.exp(jnp.sum(lq2.astype(F32) * lk2.astype(F32))) + lam_init)
    scale = DA_HEAD_DIM ** -0.5
    k_chunk = jnp.arange(seqlen) // CHUNK

    def one_block(args):
        qb, bi = args
        s = jnp.einsum('bhcqd,bhckd->bhcqk', qb, k) * scale
        q_chunk = (bi * Q_BLOCK + jnp.arange(Q_BLOCK)) // CHUNK
        mask = k_chunk[None, :] <= q_chunk[:, None]
        s = jnp.where(mask, s, -jnp.inf)
        p = jax.nn.softmax(s, axis=-1)
        w = p[:, :, 0] - lam * p[:, :, 1]
        return jnp.einsum('bhqk,bhke->bhqe', w, vv)

    o = lax.map(one_block, (qblocks, jnp.arange(nb, dtype=jnp.int32)))
    o = jnp.transpose(o, (1, 0, 3, 2, 4)).reshape(bsz, seqlen, DA_HEADS, DA_V_DIM)
    o = o * lax.rsqrt(jnp.mean(o * o, axis=-1, keepdims=True) + EPS) * head_norm.astype(F32)
    o = o * (1.0 - lam_init)
    return o.reshape(bsz, seqlen, DA_WIDTH).astype(v.dtype)


def memory_cross_attention(h, mem_n, w_xq, w_xkv, w_xo):
    bsz, seqlen, _ = h.shape
    q = (h @ w_xq).reshape(bsz, seqlen, XA_HEADS, XA_HEAD_DIM)
    kv = mem_n @ w_xkv
    k, v = jnp.split(kv, 2, axis=-1)
    k = k.reshape(bsz, -1, XA_HEADS, XA_HEAD_DIM)
    v = v.reshape(bsz, -1, XA_HEADS, XA_HEAD_DIM)
    s = jnp.einsum('blhd,bmhd->bhlm', q, k).astype(F32) * (XA_HEAD_DIM ** -0.5)
    p = jax.nn.softmax(s, axis=-1)
    o = jnp.einsum('bhlm,bmhd->blhd', p, v.astype(F32)).astype(h.dtype)
    return o.reshape(bsz, seqlen, D_MODEL) @ w_xo


def setup_inputs(seed: int = 0) -> dict:
    key = jax.random.key(seed)
    ks = iter(jax.random.split(key, 64))
    L = DEPTH

    def nrm(shape, scale):
        return scale * jax.random.normal(next(ks), shape, F32)

    def gain(width=D_MODEL):
        return 1.0 + nrm((L, width), 0.05)

    G, P, Hg = SSM_GROUPS, SSM_STATE, SSM_GROUP
    lam_im = jnp.broadcast_to(jnp.pi * jnp.arange(P, dtype=F32), (L, G, P))
    lam_re = -0.5 + jnp.clip(nrm((L, G, P), 0.01), -0.05, 0.05)
    log_dt = jax.random.uniform(next(ks), (L, G), F32, math.log(DT_MIN), math.log(DT_MAX))
    return {
        "x": nrm((BATCH, SEQ, D_MODEL), 1.0),
        "mem": nrm((BATCH, MEM_LEN, D_MODEL), 1.0),
        "norm_mix_pre": gain(),
        "w_in": nrm((L, D_MODEL, IN_COLS), D_MODEL ** -0.5),
        "b_gate": nrm((L, 2 * D_MODEL), 0.02),
        "ssm_lambda_re": lam_re,
        "ssm_lambda_im": lam_im,
        "ssm_log_dt": log_dt,
        "ssm_b_re": nrm((L, G, P, Hg), (2.0 * Hg) ** -0.5),
        "ssm_b_im": nrm((L, G, P, Hg), (2.0 * Hg) ** -0.5),
        "ssm_c_re": nrm((L, G, Hg, P), (2.0 * P) ** -0.5),
        "ssm_c_im": nrm((L, G, Hg, P), (2.0 * P) ** -0.5),
        "ssm_d": nrm((L, SSM_WIDTH), 1.0),
        "w_glu": nrm((L, SSM_WIDTH, SSM_WIDTH), SSM_WIDTH ** -0.5),
        "b_glu": nrm((L, SSM_WIDTH), 0.02),
        "w_ssm_proj": nrm((L, SSM_WIDTH, D_MODEL), SSM_WIDTH ** -0.5),
        "da_lambda_q1": nrm((L, DA_HEAD_DIM), 0.1),
        "da_lambda_k1": nrm((L, DA_HEAD_DIM), 0.1),
        "da_lambda_q2": nrm((L, DA_HEAD_DIM), 0.1),
        "da_lambda_k2": nrm((L, DA_HEAD_DIM), 0.1),
        "da_head_norm": gain(DA_V_DIM),
        "w_da_proj": nrm((L, DA_WIDTH, D_MODEL), DA_WIDTH ** -0.5),
        "w_mix_out": nrm((L, D_MODEL, D_MODEL), D_MODEL ** -0.5),
        "norm_mix_post": gain(),
        "norm_x_pre": gain(),
        "norm_mem": gain(),
        "w_xq": nrm((L, D_MODEL, D_MODEL), D_MODEL ** -0.5),
        "w_xkv": nrm((L, D_MODEL, 2 * D_MODEL), D_MODEL ** -0.5),
        "w_xo": nrm((L, D_MODEL, D_MODEL), D_MODEL ** -0.5),
        "norm_x_post": gain(),
        "norm_ff_pre": gain(),
        "w_ff1": nrm((L, D_MODEL, D_FF), D_MODEL ** -0.5),
        "w_ff2": nrm((L, D_FF, D_MODEL), D_FF ** -0.5),
        "norm_ff_post": gain(),
    }


def reference(x, mem, norm_mix_pre, w_in, b_gate, ssm_lambda_re, ssm_lambda_im, ssm_log_dt,
              ssm_b_re, ssm_b_im, ssm_c_re, ssm_c_im, ssm_d, w_glu, b_glu, w_ssm_proj,
              da_lambda_q1, da_lambda_k1, da_lambda_q2, da_lambda_k2, da_head_norm, w_da_proj,
              w_mix_out, norm_mix_post, norm_x_pre, norm_mem, w_xq, w_xkv, w_xo, norm_x_post,
              norm_ff_pre, w_ff1, w_ff2, norm_ff_post):
    for l in range(DEPTH):
        lam_init = 0.8 - 0.6 * math.exp(-0.3 * l)
        h = rms_norm(x, norm_mix_pre[l])
        z = h @ w_in[l]
        u_s, q, k, v, g = jnp.split(z, [COL_SSM, COL_Q, COL_K, COL_V], axis=-1)
        ys = s5_branch(u_s, ssm_lambda_re[l], ssm_lambda_im[l], ssm_log_dt[l],
                       ssm_b_re[l], ssm_b_im[l], ssm_c_re[l], ssm_c_im[l], ssm_d[l])
        ys = jax.nn.gelu(ys)
        ys = ys * jax.nn.sigmoid(ys @ w_glu[l] + b_glu[l])
        branch_a = ys @ w_ssm_proj[l]
        ya = diff_attention(q, k, v, da_lambda_q1[l], da_lambda_k1[l], da_lambda_q2[l],
                            da_lambda_k2[l], da_head_norm[l], lam_init)
        branch_b = ya @ w_da_proj[l]
        gates = jax.nn.sigmoid((g + b_gate[l]).astype(F32))
        g_a, g_b = jnp.split(gates, 2, axis=-1)
        merged = (g_a * branch_a.astype(F32) + g_b * branch_b.astype(F32)).astype(x.dtype)
        x = x + rms_norm(merged @ w_mix_out[l], norm_mix_post[l])
        h = rms_norm(x, norm_x_pre[l])
        mem_n = rms_norm(mem, norm_mem[l])
        x = x + rms_norm(memory_cross_attention(h, mem_n, w_xq[l], w_xkv[l], w_xo[l]), norm_x_post[l])
        h = rms_norm(x, norm_ff_pre[l])
        f = jnp.square(jax.nn.relu(h @ w_ff1[l])) @ w_ff2[l]
        x = x + rms_norm(f, norm_ff_post[l])
    return x
```

```cpp
#include <hip/hip_runtime.h>
#include <cstdio>
#include <cstdint>

#ifndef MK_N_LAUNCHES
#define MK_N_LAUNCHES 1
#endif

#define GAS __attribute__((address_space(1)))
#define LAS __attribute__((address_space(3)))
typedef unsigned short bf16;
typedef unsigned v4u __attribute__((ext_vector_type(4)));
typedef unsigned v2u __attribute__((ext_vector_type(2)));
typedef float f32x4 __attribute__((ext_vector_type(4)));
typedef GAS unsigned gu32;
#define RLX_AGENT __ATOMIC_RELAXED, __HIP_MEMORY_SCOPE_AGENT
#define LDS_WAIT() asm volatile("s_waitcnt lgkmcnt(0)" ::: "memory")
#define VM_WAIT() asm volatile("s_waitcnt vmcnt(0)" ::: "memory")

constexpr int BATCH = 2, SEQ = 8192, D = 1024, M = BATCH * SEQ, INC = 6144, FF = 4096, MEML = 256, MM = BATCH * MEML;
constexpr int SG = 64, SH = 16, SP = 64;
constexpr int CH = 64, NCH = SEQ / CH;
constexpr float EPS = 1e-6f;
constexpr float LOG2E = 1.4426950408889634f;
constexpr float QSCALE = 0.125f * LOG2E;
constexpr float XSCALE = 0.0625f * LOG2E;
constexpr float LAM_INIT = 0.2f;

constexpr size_t MiB = 1u << 20;
constexpr size_t WS_CTL = 0, CTL_ZERO_BYTES = 64 * 1024;
constexpr size_t WS_SCAL = 64 * 1024;
constexpr size_t WS_SSMP = 128 * 1024;
constexpr size_t WS_COS = 1 * MiB, WS_SIN = 2 * MiB;
constexpr size_t WS_MEMN = 3 * MiB;
constexpr size_t WS_KVM = 4 * MiB;
constexpr size_t WS_WIN = 8 * MiB;
constexpr size_t WS_WGLU = 20 * MiB, WS_WSSM = 22 * MiB, WS_WDA = 24 * MiB, WS_WMIX = 26 * MiB, WS_WXQ = 28 * MiB, WS_WXO = 30 * MiB;
constexpr size_t WS_WXKV = 32 * MiB;
constexpr size_t WS_WF1 = 36 * MiB;
constexpr size_t WS_WF2 = 44 * MiB;
constexpr size_t WS_H = 52 * MiB, WS_U = 84 * MiB, WS_Q = 116 * MiB, WS_K = 148 * MiB, WS_V = 180 * MiB;
constexpr size_t WS_E = 212 * MiB, WS_SIN_C = 220 * MiB;
constexpr size_t WS_END = 228 * MiB;
constexpr int CW_BAR = 1024;

constexpr int RING_BYTES = 131072, LDSCTL_OFF = RING_BYTES, MISC_OFF = LDSCTL_OFF + 320, LDS_BYTES = 147456;
constexpr int NWAVES = 8;

__device__ __forceinline__ unsigned f2bf(float f) { unsigned u = __builtin_bit_cast(unsigned, f); return (u + 0x7fffu + ((u >> 16) & 1u)) >> 16; }
__device__ __forceinline__ unsigned pk2(float lo, float hi) { return f2bf(lo) | (f2bf(hi) << 16); }
__device__ __forceinline__ float bf2f(unsigned short h) { return __builtin_bit_cast(float, (unsigned)h << 16); }
__device__ __forceinline__ float bflo(unsigned w) { return __builtin_bit_cast(float, w << 16); }
__device__ __forceinline__ float bfhi(unsigned w) { return __builtin_bit_cast(float, w & 0xffff0000u); }

#define XB_TMO      128
#define XB_XCNT(j)  (256  + 64 * (j))
#define XB_XSUB(j)  (1280 + 64 * (j))
#define XB_XGEN(j)  (2304 + 64 * (j))
#define XB_TOP      3328
#define XB_TOPGEN   3392
#define XCD_BAR_WORDS 3456
#define XB_SPIN_CAP (1u << 18)
__device__ __forceinline__ unsigned xb_ld(unsigned* p)              { return __hip_atomic_load(p, __ATOMIC_RELAXED, __HIP_MEMORY_SCOPE_AGENT); }
__device__ __forceinline__ unsigned xb_add(unsigned* p, unsigned v) { return __hip_atomic_fetch_add(p, v, __ATOMIC_RELAXED, __HIP_MEMORY_SCOPE_AGENT); }
__device__ __forceinline__ unsigned xb_xcc_id() { return (unsigned)__builtin_amdgcn_s_getreg((3 << 11) | 20) & 0xFu; }
#define XB_SPIN(cond, bar) do { unsigned _sp = 0; while (cond) { __builtin_amdgcn_s_sleep(1); \
    if ((++_sp & 255u) == 0u) { if (xb_ld(&(bar)[XB_TMO])) break; if (_sp > XB_SPIN_CAP) { atomicAdd(&(bar)[XB_TMO], 1u); break; } } } } while (0)
struct XcdBarrier { unsigned* bar; unsigned x; volatile LAS unsigned* st; };
__device__ __forceinline__ XcdBarrier xcd_barrier_post(unsigned* bar, volatile LAS unsigned* st) {
    XcdBarrier b; b.bar = bar; b.x = xb_xcc_id(); b.st = st;
    if (threadIdx.x == 0) (void)xb_add(&bar[XB_XCNT(b.x)], 1u);
    return b;
}
__device__ __forceinline__ void xcd_barrier_complete(unsigned* bar, unsigned x, unsigned& nloc, unsigned& nx) {
    const unsigned G = gridDim.x * gridDim.y * gridDim.z;
    unsigned sum, cnt, mine, sp = 0u;
    for (;;) {
        sum = 0u; cnt = 0u; mine = 0u;
#pragma unroll
        for (unsigned j = 0; j < 16; ++j) { const unsigned c = xb_ld(&bar[XB_XCNT(j)]); sum += c; cnt += (c > 0u) ? 1u : 0u; mine = (j == x) ? c : mine; }
        if (sum == G) break;
        __builtin_amdgcn_s_sleep(1);
        if ((++sp & 255u) == 0u) { if (xb_ld(&bar[XB_TMO])) break; if (sp > XB_SPIN_CAP) { atomicAdd(&bar[XB_TMO], 1u); break; } }
    }
    nloc = mine > 0u ? mine : 1u; nx = cnt > 0u ? cnt : 1u;
}
__device__ __forceinline__ void xcd_barrier(const XcdBarrier& b) {
    asm volatile("s_waitcnt vmcnt(0)" ::: "memory");
    __syncthreads();
    if (threadIdx.x == 0) {
        unsigned* bar = b.bar;
        __builtin_amdgcn_s_waitcnt(0);
        unsigned nloc = b.st[0], nx = b.st[1];
        if (nloc == 0u) { xcd_barrier_complete(bar, b.x, nloc, nx); b.st[0] = nloc; b.st[1] = nx; }
        const unsigned old = xb_add(&bar[XB_XSUB(b.x)], 1u);
        const unsigned gen = old / nloc;
        if (old + 1u == (gen + 1u) * nloc) {
            __builtin_amdgcn_fence(__ATOMIC_RELEASE, "agent");
            asm volatile("s_waitcnt vmcnt(0)" ::: "memory");
            const unsigned og = xb_add(&bar[XB_TOP], 1u);
            const unsigned tg = og / nx;
            if (og + 1u == (tg + 1u) * nx) xb_add(&bar[XB_TOPGEN], 1u);
            else XB_SPIN(xb_ld(&bar[XB_TOPGEN]) == tg, bar);
            __builtin_amdgcn_fence(__ATOMIC_ACQUIRE, "agent");
            xb_add(&bar[XB_XGEN(b.x)], 1u);
            asm volatile("s_waitcnt vmcnt(0)" ::: "memory");
        } else {
            XB_SPIN(xb_ld(&bar[XB_XGEN(b.x)]) == gen, bar);
            __builtin_amdgcn_fence(__ATOMIC_ACQUIRE, "agent");
            asm volatile("s_waitcnt vmcnt(0)" ::: "memory");
        }
    }
    __syncthreads();
}

struct Frame {
    LAS unsigned char* lds;
    int tid, lane, wave, vcu, G;
    const float* const* in;
};
struct Args { const float* in[34]; float* out; unsigned char* ws; int ph_lo, ph_hi, li, pad; };

__device__ __forceinline__ float wave_sum(float v) {
#pragma unroll
    for (int o = 1; o < 64; o <<= 1) v += __shfl_xor(v, o);
    return v;
}

__device__ __forceinline__ void p0_transpose_item(const float* W, int K, int N, bf16* WT, LAS float* scr, int item, int lane) {
    const int nblk = N / 32, kb = item / nblk, nb = item % nblk, k0 = 64 * kb, n0 = 32 * nb;
#pragma unroll 8
    for (int i = 0; i < 32; ++i) { const int kk = 2 * i + (lane >> 5); scr[kk * 33 + (lane & 31)] = W[(size_t)(k0 + kk) * N + n0 + (lane & 31)]; }
    LDS_WAIT(); asm volatile("" ::: "memory");
    const int c = lane & 7;
#pragma unroll
    for (int j = 0; j < 4; ++j) { const int n = (lane >> 3) + 8 * j; const LAS float* s = scr + (8 * c) * 33 + n;
        v4u o; o.x = pk2(s[0 * 33], s[1 * 33]); o.y = pk2(s[2 * 33], s[3 * 33]); o.z = pk2(s[4 * 33], s[5 * 33]); o.w = pk2(s[6 * 33], s[7 * 33]);
        *(GAS v4u*)(WT + (size_t)(n0 + n) * K + k0 + 8 * c) = o; }
    LDS_WAIT(); asm volatile("" ::: "memory");
}
__device__ __forceinline__ void rms_row_to_bf16(const float* xrow, const float* g, bf16* orow, int lane) {
    const GAS f32x4* xr = (const GAS f32x4*)xrow + lane; const GAS f32x4* gr = (const GAS f32x4*)g + lane;
    f32x4 v[4]; float s = 0.f;
#pragma unroll
    for (int j = 0; j < 4; ++j) { v[j] = xr[64 * j]; s += (v[j].x * v[j].x + v[j].y * v[j].y) + (v[j].z * v[j].z + v[j].w * v[j].w); }
    const float rs = 1.0f / sqrtf(wave_sum(s) * (1.f / D) + EPS);
    GAS v2u* o8 = (GAS v2u*)orow + lane;
#pragma unroll
    for (int j = 0; j < 4; ++j) { const f32x4 gg = gr[64 * j]; v2u w; w.x = pk2(v[j].x * rs * gg.x, v[j].y * rs * gg.y); w.y = pk2(v[j].z * rs * gg.z, v[j].w * rs * gg.w); o8[64 * j] = w; }
}
__device__ __forceinline__ void resnorm_row(const bf16* yrow, const float* xi, const float* g1, float* xo, const float* g2, bf16* hn, int lane) {
    const GAS v2u* yr = (const GAS v2u*)yrow + lane; const GAS f32x4* xr = (const GAS f32x4*)xi + lane; const GAS f32x4* g1r = (const GAS f32x4*)g1 + lane;
    f32x4 y[4], x[4]; float s = 0.f;
#pragma unroll
    for (int j = 0; j < 4; ++j) { const v2u w = yr[64 * j]; y[j] = (f32x4){bflo(w.x), bfhi(w.x), bflo(w.y), bfhi(w.y)}; x[j] = xr[64 * j];
        s += (y[j].x * y[j].x + y[j].y * y[j].y) + (y[j].z * y[j].z + y[j].w * y[j].w); }
    const float rs = 1.0f / sqrtf(wave_sum(s) * (1.f / D) + EPS);
    float s2 = 0.f;
#pragma unroll
    for (int j = 0; j < 4; ++j) { const f32x4 gg = g1r[64 * j]; x[j] = x[j] + y[j] * rs * gg; s2 += (x[j].x * x[j].x + x[j].y * x[j].y) + (x[j].z * x[j].z + x[j].w * x[j].w); }
    GAS f32x4* xw = (GAS f32x4*)xo + lane;
#pragma unroll
    for (int j = 0; j < 4; ++j) xw[64 * j] = x[j];
    if (hn) {
        const float rs2 = 1.0f / sqrtf(wave_sum(s2) * (1.f / D) + EPS);
        const GAS f32x4* g2r = (const GAS f32x4*)g2 + lane; GAS v2u* o8 = (GAS v2u*)hn + lane;
#pragma unroll
        for (int j = 0; j < 4; ++j) { const f32x4 gg = g2r[64 * j]; v2u w; w.x = pk2(x[j].x * rs2 * gg.x, x[j].y * rs2 * gg.y); w.y = pk2(x[j].z * rs2 * gg.z, x[j].w * rs2 * gg.w); o8[64 * j] = w; }
    }
}

__device__ __forceinline__ double rope_inv(int i) {
    const double r = 0.74989420933245582730218427561514;
    double v = 1.0;
    for (int k = 0; k < i; ++k) v *= r;
    return v;
}
__device__ __forceinline__ void sincos_reduced(double ang, float& c, float& s) {
    const double inv2pi = 0.15915494309189533576888376337251;
    const double twopi = 6.283185307179586476925286766559;
    const double k = __builtin_rint(ang * inv2pi);
    const float r = (float)(ang - k * twopi);
    c = cosf(r); s = sinf(r);
}

constexpr int NG_LD = 132, NG_TLD = 129;
template <class Epi>
__device__ __forceinline__ void ngemm(LAS unsigned char* lds, const bf16* A, int lda, const bf16* B, int sbk, int sbn, int Mr, int Nc, int Kd, const Epi& epi, int vcu, int G) {
    LAS float* As = (LAS float*)lds; LAS float* Bs = As + 16 * NG_LD; LAS float* T = Bs + 16 * NG_LD;
    const int tid = threadIdx.x, ty = tid >> 4, tx = tid & 15;
    const int nTn = Nc / 128, nT = (Mr / 128) * nTn;
    for (int tile = vcu; tile < nT; tile += G) {
        const int tm = tile / nTn, tn = tile % nTn;
        float acc[4][8];
#pragma unroll
        for (int i = 0; i < 4; ++i)
#pragma unroll
            for (int j = 0; j < 8; ++j) acc[i][j] = 0.f;
        const int lr = tid >> 2, lk = (tid & 3) * 4;
        for (int k0 = 0; k0 < Kd; k0 += 16) {
            { const bf16* ap = A + (size_t)(tm * 128 + lr) * lda + k0 + lk;
#pragma unroll
              for (int j = 0; j < 4; ++j) As[(lk + j) * NG_LD + lr] = bf2f(ap[j]); }
            { const bf16* bp = B + (size_t)(k0 + lk) * sbk + (size_t)(tn * 128 + lr) * sbn;
#pragma unroll
              for (int j = 0; j < 4; ++j) Bs[(lk + j) * NG_LD + lr] = bf2f(bp[(size_t)j * sbk]); }
            __syncthreads();
#pragma unroll
            for (int kk = 0; kk < 16; ++kk) {
                const f32x4 a = *(const LAS f32x4*)(As + kk * NG_LD + ty * 4);
                const f32x4 b0 = *(const LAS f32x4*)(Bs + kk * NG_LD + tx * 8), b1 = *(const LAS f32x4*)(Bs + kk * NG_LD + tx * 8 + 4);
#pragma unroll
                for (int i = 0; i < 4; ++i) {
#pragma unroll
                    for (int j = 0; j < 4; ++j) { acc[i][j] += a[i] * b0[j]; acc[i][4 + j] += a[i] * b1[j]; }
                }
            }
            __syncthreads();
        }
#pragma unroll
        for (int i = 0; i < 4; ++i)
#pragma unroll
            for (int j = 0; j < 8; ++j) T[(ty * 4 + i) * NG_TLD + tx * 8 + j] = acc[i][j];
        __syncthreads();
        for (int idx = tid; idx < 128 * 128; idx += 512) { const int r = idx >> 7, c = idx & 127; epi(tm * 128 + r, tn * 128 + c, T, r, c); }
        __syncthreads();
    }
}
__device__ __forceinline__ float sigmoidf_(float v) { return 1.0f / (1.0f + __expf(-v)); }
__device__ __forceinline__ float gelu_tanh(float x) { const float u = 0.7978845608028654f * (x + 0.044715f * x * x * x); return x / (1.0f + __expf(-2.0f * u)); }

struct EpiStore { bf16* O; int ld; float scale;
    __device__ __forceinline__ void operator()(int row, int col, const LAS float* T, int r, int c) const { O[(size_t)row * ld + col] = (bf16)f2bf(T[r * NG_TLD + c] * scale); } };
struct EpiStoreF32 { float* O; int ld;
    __device__ __forceinline__ void operator()(int row, int col, const LAS float* T, int r, int c) const { O[(size_t)row * ld + col] = T[r * NG_TLD + c]; } };
struct EpiInProj { bf16 *U, *Q, *K, *V, *Gt; const float *cosT, *sinT, *bgate;
    __device__ __forceinline__ void operator()(int row, int col, const LAS float* T, int r, int c) const {
        const float v = T[r * NG_TLD + c];
        if (col < 1024) { U[(size_t)row * D + col] = (bf16)f2bf(v); return; }
        if (col < 3072) { const int cc = (col - 1024) & 1023, d = cc & 63, i = d & 31, pos = row & (SEQ - 1);
            const float cs = cosT[pos * 32 + i], sn = sinT[pos * 32 + i];
            const float o = (d < 32) ? (v * cs - T[r * NG_TLD + c + 32] * sn) : (v * cs + T[r * NG_TLD + c - 32] * sn);
            if (col < 2048) Q[(size_t)row * D + cc] = (bf16)f2bf(o * QSCALE); else K[(size_t)row * D + cc] = (bf16)f2bf(o);
            return; }
        if (col < 4096) { V[(size_t)row * D + (col - 3072)] = (bf16)f2bf(v); return; }
        Gt[(size_t)row * 2048 + (col - 4096)] = (bf16)f2bf(sigmoidf_(v + bgate[col - 4096]));
    } };
struct EpiGlu { const bf16* YS; bf16* O; const float* bglu;
    __device__ __forceinline__ void operator()(int row, int col, const LAS float* T, int r, int c) const {
        const float t = T[r * NG_TLD + c] + bglu[col]; const float ys = bf2f(YS[(size_t)row * D + col]);
        O[(size_t)row * D + col] = (bf16)f2bf(ys * sigmoidf_(t)); } };
struct EpiMergeA { const bf16* Gt; float* TMP;
    __device__ __forceinline__ void operator()(int row, int col, const LAS float* T, int r, int c) const {
        TMP[(size_t)row * D + col] = bf2f(Gt[(size_t)row * 2048 + col]) * T[r * NG_TLD + c]; } };
struct EpiMergeB { const bf16* Gt; const float* TMP; bf16* O;
    __device__ __forceinline__ void operator()(int row, int col, const LAS float* T, int r, int c) const {
        O[(size_t)row * D + col] = (bf16)f2bf(TMP[(size_t)row * D + col] + bf2f(Gt[(size_t)row * 2048 + 1024 + col]) * T[r * NG_TLD + c]); } };
struct EpiRelu2 { bf16* O; int ld;
    __device__ __forceinline__ void operator()(int row, int col, const LAS float* T, int r, int c) const { const float v = fmaxf(T[r * NG_TLD + c], 0.f); O[(size_t)row * ld + col] = (bf16)f2bf(v * v); } };

__global__ void __launch_bounds__(NWAVES * 64, 2) mk_fwd(Args args) {
    extern __shared__ __attribute__((aligned(16))) unsigned char lds_raw[];
    LAS unsigned char* lds = (LAS unsigned char*)lds_raw;
    volatile LAS unsigned* MISC = (volatile LAS unsigned*)(lds + MISC_OFF);
    const int tid = threadIdx.x, lane = tid & 63, wave = __builtin_amdgcn_readfirstlane(tid >> 6);
    const int G = gridDim.x; const int bx = blockIdx.x; const int vcu = (G % 8 == 0) ? (bx % 8) * (G / 8) + bx / 8 : bx;
    unsigned char* ws = args.ws;
    gu32* ctl = (gu32*)(ws + WS_CTL);
    for (int u = tid; u < (LDS_BYTES - LDSCTL_OFF) / 4; u += NWAVES * 64) ((LAS unsigned*)(lds + LDSCTL_OFF))[u] = 0u;
    __syncthreads();
    XcdBarrier bar; bar.bar = (unsigned*)(ctl + CW_BAR); bar.x = 0; bar.st = nullptr;
    if (MK_N_LAUNCHES == 1) bar = xcd_barrier_post((unsigned*)(ctl + CW_BAR), MISC + 8);
    const int lo = args.ph_lo, hi = args.ph_hi;
#define IN(k) (lo <= (k) && (k) < hi)
#define SEAM(k) do { if (IN(k) && IN((k) + 1)) xcd_barrier(bar); } while (0)

    const float* x = args.in[0]; const float* mem = args.in[1]; const float* g_mix_pre = args.in[2]; const float* w_in = args.in[3]; const float* b_gate = args.in[4];
    const float* lam_re = args.in[5]; const float* lam_im = args.in[6]; const float* log_dt = args.in[7]; const float* sb_re = args.in[8]; const float* sb_im = args.in[9];
    const float* sc_re = args.in[10]; const float* sc_im = args.in[11]; const float* ssm_d = args.in[12]; const float* w_glu = args.in[13]; const float* b_glu = args.in[14];
    const float* w_ssm = args.in[15]; const float* lq1 = args.in[16]; const float* lk1 = args.in[17]; const float* lq2 = args.in[18]; const float* lk2 = args.in[19];
    const float* head_norm = args.in[20]; const float* w_da = args.in[21]; const float* w_mix = args.in[22]; const float* g_mix_post = args.in[23]; const float* g_x_pre = args.in[24];
    const float* g_mem = args.in[25]; const float* w_xq = args.in[26]; const float* w_xkv = args.in[27]; const float* w_xo = args.in[28]; const float* g_x_post = args.in[29];
    const float* g_ff_pre = args.in[30]; const float* w_ff1 = args.in[31]; const float* w_ff2 = args.in[32]; const float* g_ff_post = args.in[33];
    float* out = args.out;
    float* scal = (float*)(ws + WS_SCAL); float* lamb = (float*)(ws + WS_SSMP); float* bbar = lamb + SG * SP * 4;
    float* cosT = (float*)(ws + WS_COS); float* sinT = (float*)(ws + WS_SIN);
    bf16* MEMN = (bf16*)(ws + WS_MEMN); bf16* KVM = (bf16*)(ws + WS_KVM);
    bf16* Win = (bf16*)(ws + WS_WIN); bf16* Wglu = (bf16*)(ws + WS_WGLU); bf16* Wssm = (bf16*)(ws + WS_WSSM); bf16* Wda = (bf16*)(ws + WS_WDA); bf16* Wmix = (bf16*)(ws + WS_WMIX);
    bf16* Wxq = (bf16*)(ws + WS_WXQ); bf16* Wxo = (bf16*)(ws + WS_WXO); bf16* Wxkv = (bf16*)(ws + WS_WXKV); bf16* Wf1 = (bf16*)(ws + WS_WF1); bf16* Wf2 = (bf16*)(ws + WS_WF2);
    bf16* HB = (bf16*)(ws + WS_H); bf16* UB = (bf16*)(ws + WS_U); bf16* QB = (bf16*)(ws + WS_Q); bf16* KB = (bf16*)(ws + WS_K); bf16* VB = (bf16*)(ws + WS_V);
    bf16* GT = (bf16*)out;
    float* EB = (float*)(ws + WS_E); float* SINB = (float*)(ws + WS_SIN_C);
    const int gw = vcu * NWAVES + wave, NGW = G * NWAVES;

    if (IN(0)) {
        LAS float* scr = (LAS float*)(lds + wave * 16384);
        constexpr int I_IN = 16 * 192, I_SQ = 16 * 32, I_KV = 16 * 64, I_F1 = 16 * 128, I_F2 = 64 * 32;
        constexpr int NITEMS = I_IN + 6 * I_SQ + I_KV + I_F1 + I_F2;
        for (int it = gw; it < NITEMS; it += NGW) {
            int r = it;
            if (r < I_IN) { p0_transpose_item(w_in, D, INC, Win, scr, r, lane); continue; } r -= I_IN;
            if (r < I_SQ) { p0_transpose_item(w_glu, D, D, Wglu, scr, r, lane); continue; } r -= I_SQ;
            if (r < I_SQ) { p0_transpose_item(w_ssm, D, D, Wssm, scr, r, lane); continue; } r -= I_SQ;
            if (r < I_SQ) { p0_transpose_item(w_da, D, D, Wda, scr, r, lane); continue; } r -= I_SQ;
            if (r < I_SQ) { p0_transpose_item(w_mix, D, D, Wmix, scr, r, lane); continue; } r -= I_SQ;
            if (r < I_SQ) { p0_transpose_item(w_xq, D, D, Wxq, scr, r, lane); continue; } r -= I_SQ;
            if (r < I_SQ) { p0_transpose_item(w_xo, D, D, Wxo, scr, r, lane); continue; } r -= I_SQ;
            if (r < I_KV) { p0_transpose_item(w_xkv, D, 2 * D, Wxkv, scr, r, lane); continue; } r -= I_KV;
            if (r < I_F1) { p0_transpose_item(w_ff1, D, FF, Wf1, scr, r, lane); continue; } r -= I_F1;
            p0_transpose_item(w_ff2, FF, D, Wf2, scr, r, lane);
        }
        for (int m = gw; m < M; m += NGW) rms_row_to_bf16(x + (size_t)m * D, g_mix_pre, HB + (size_t)m * D, lane);
        for (int m = gw; m < MM; m += NGW) rms_row_to_bf16(mem + (size_t)m * D, g_mem, MEMN + (size_t)m * D, lane);
        for (int idx = vcu * 512 + tid; idx < SEQ * 32; idx += G * 512) { const int pos = idx >> 5, i = idx & 31; float c, s; sincos_reduced((double)pos * rope_inv(i), c, s); cosT[idx] = c; sinT[idx] = s; }
        for (int idx = vcu * 512 + tid; idx < SG * SP; idx += G * 512) {
            const int g = idx >> 6;
            const double lr = (double)lam_re[idx], li = (double)lam_im[idx], dt = exp((double)log_dt[g]);
            const double zr = lr * dt, zi = li * dt;
            float c1, s1; sincos_reduced(zi, c1, s1);
            const double er = exp(zr), br = er * (double)c1, bi = er * (double)s1;
            float c64, s64; sincos_reduced(64.0 * zi, c64, s64);
            const double e64 = exp(64.0 * zr);
            lamb[idx * 4 + 0] = (float)br; lamb[idx * 4 + 1] = (float)bi; lamb[idx * 4 + 2] = (float)(e64 * (double)c64); lamb[idx * 4 + 3] = (float)(e64 * (double)s64);
            const double nr = br - 1.0, ni = bi, den = lr * lr + li * li;
            const double fr = (nr * lr + ni * li) / den, fi = (ni * lr - nr * li) / den;
            for (int h = 0; h < SH; ++h) { const double b_r = (double)sb_re[idx * SH + h], b_i = (double)sb_im[idx * SH + h];
                bbar[idx * 32 + h] = (float)(fr * b_r - fi * b_i); bbar[idx * 32 + 16 + h] = (float)(fr * b_i + fi * b_r); }
        }
        if (vcu == 0 && wave == 0) {
            const float a = wave_sum(lq1[lane] * lk1[lane]), b = wave_sum(lq2[lane] * lk2[lane]);
            if (lane == 0) scal[0] = expf(a) - expf(b) + LAM_INIT;
        }
    }
    SEAM(0);
    if (IN(1)) {
        EpiInProj e{UB, QB, KB, VB, GT, cosT, sinT, b_gate};
        ngemm(lds, HB, D, Win, 1, D, M, INC, D, e, vcu, G);
        EpiStore e2{KVM, 2 * D, 1.0f};
        ngemm(lds, MEMN, D, Wxkv, 1, D, MM, 2 * D, D, e2, vcu, G);
    }
    SEAM(1);
    if (IN(2)) {
        for (int unit = gw; unit < BATCH * SG * NCH; unit += NGW) {
            const int c = unit % NCH, g = (unit / NCH) % SG, b = unit / (NCH * SG);
            const int gp = g * SP + lane;
            const float lbr = lamb[gp * 4 + 0], lbi = lamb[gp * 4 + 1];
            float br[16], bi[16];
#pragma unroll
            for (int h = 0; h < 16; ++h) { br[h] = bbar[gp * 32 + h]; bi[h] = bbar[gp * 32 + 16 + h]; }
            float xr = 0.f, xi = 0.f;
            const bf16* up = UB + (size_t)(b * SEQ + c * CH) * D + g * SH;
            for (int t = 0; t < CH; ++t) {
                const v4u w0 = *(const GAS v4u*)(up + (size_t)t * D), w1 = *(const GAS v4u*)(up + (size_t)t * D + 8);
                const float u[16] = {bflo(w0.x), bfhi(w0.x), bflo(w0.y), bfhi(w0.y), bflo(w0.z), bfhi(w0.z), bflo(w0.w), bfhi(w0.w), bflo(w1.x), bfhi(w1.x), bflo(w1.y), bfhi(w1.y), bflo(w1.z), bfhi(w1.z), bflo(w1.w), bfhi(w1.w)};
                float ar = 0.f, ai = 0.f;
#pragma unroll
                for (int h = 0; h < 16; ++h) { ar += br[h] * u[h]; ai += bi[h] * u[h]; }
                const float nr = lbr * xr - lbi * xi + ar, ni = lbr * xi + lbi * xr + ai; xr = nr; xi = ni;
            }
            float* e = EB + ((size_t)((b * SG + g) * NCH + c) * SP + lane) * 2; e[0] = xr; e[1] = xi;
        }
    }
    SEAM(2);
    if (IN(3)) {
        for (int idx = vcu * 512 + tid; idx < BATCH * SG * SP; idx += G * 512) {
            const int p = idx & 63, g = (idx >> 6) & 63, b = idx >> 12; const int gp = g * SP + p;
            const float tr = lamb[gp * 4 + 2], ti = lamb[gp * 4 + 3];
            float sr = 0.f, si = 0.f;
            const size_t base = ((size_t)(b * SG + g) * NCH) * SP + p;
            for (int c = 0; c < NCH; ++c) {
                const size_t o = (base + (size_t)c * SP) * 2;
                SINB[o] = sr; SINB[o + 1] = si;
                const float er = EB[o], ei = EB[o + 1];
                const float nr = tr * sr - ti * si + er, ni = tr * si + ti * sr + ei; sr = nr; si = ni;
            }
        }
    }
    SEAM(3);
    if (IN(4)) {
        LAS float* xs = (LAS float*)(lds + wave * 1024);
        for (int unit = gw; unit < BATCH * SG * NCH; unit += NGW) {
            const int c = unit % NCH, g = (unit / NCH) % SG, b = unit / (NCH * SG);
            const int gp = g * SP + lane;
            const float lbr = lamb[gp * 4 + 0], lbi = lamb[gp * 4 + 1];
            float br[16], bi[16], cr[16], ci[16];
#pragma unroll
            for (int h = 0; h < 16; ++h) { br[h] = bbar[gp * 32 + h]; bi[h] = bbar[gp * 32 + 16 + h]; }
            const int hh = lane & 15, pq = lane >> 4;
#pragma unroll
            for (int j = 0; j < 16; ++j) { cr[j] = sc_re[(size_t)(g * SH + hh) * SP + pq * 16 + j]; ci[j] = sc_im[(size_t)(g * SH + hh) * SP + pq * 16 + j]; }
            const float dsk = ssm_d[g * SH + hh];
            const float* sp = SINB + ((size_t)((b * SG + g) * NCH + c) * SP + lane) * 2;
            float xr = sp[0], xi = sp[1];
            const bf16* up = UB + (size_t)(b * SEQ + c * CH) * D + g * SH;
            bf16* yp = HB + (size_t)(b * SEQ + c * CH) * D + g * SH;
            for (int t = 0; t < CH; ++t) {
                const v4u w0 = *(const GAS v4u*)(up + (size_t)t * D), w1 = *(const GAS v4u*)(up + (size_t)t * D + 8);
                const float u[16] = {bflo(w0.x), bfhi(w0.x), bflo(w0.y), bfhi(w0.y), bflo(w0.z), bfhi(w0.z), bflo(w0.w), bfhi(w0.w), bflo(w1.x), bfhi(w1.x), bflo(w1.y), bfhi(w1.y), bflo(w1.z), bfhi(w1.z), bflo(w1.w), bfhi(w1.w)};
                float ar = 0.f, ai = 0.f;
#pragma unroll
                for (int h = 0; h < 16; ++h) { ar += br[h] * u[h]; ai += bi[h] * u[h]; }
                const float nr = lbr * xr - lbi * xi + ar, ni = lbr * xi + lbi * xr + ai; xr = nr; xi = ni;
                xs[lane] = xr; xs[64 + lane] = xi;
                LDS_WAIT(); asm volatile("" ::: "memory");
                float y = 0.f;
#pragma unroll
                for (int j = 0; j < 16; ++j) y += cr[j] * xs[pq * 16 + j] - ci[j] * xs[64 + pq * 16 + j];
                y += __shfl_xor(y, 16); y += __shfl_xor(y, 32);
                float uh = u[0];
#pragma unroll
                for (int h = 1; h < 16; ++h) uh = (hh == h) ? u[h] : uh;
                y += dsk * uh;
                if (lane < 16) yp[(size_t)t * D + hh] = (bf16)f2bf(gelu_tanh(y));
                LDS_WAIT(); asm volatile("" ::: "memory");
            }
        }
    }
    SEAM(4);
    if (IN(5)) {
        const float lam = scal[0];
        const int row = tid >> 3, sl = tid & 7;
        for (int i = 0; i < 8; ++i) {
            const int slot = (i & 1) ? (i * 256 + 255 - vcu) : (i * 256 + vcu);
            if (slot >= BATCH * 8 * 128) break;
            const int qc = 127 - (slot >> 4), bh = slot & 15, b = bh >> 3, h = bh & 7;
            const size_t rbase = (size_t)b * SEQ;
            const bf16* qp = QB + (rbase + qc * 64 + row) * D + h * 128;
            float q1[64], q2[64];
#pragma unroll
            for (int c8 = 0; c8 < 8; ++c8) { const v4u w = *(const GAS v4u*)(qp + c8 * 8); q1[c8 * 8 + 0] = bflo(w.x); q1[c8 * 8 + 1] = bfhi(w.x); q1[c8 * 8 + 2] = bflo(w.y); q1[c8 * 8 + 3] = bfhi(w.y); q1[c8 * 8 + 4] = bflo(w.z); q1[c8 * 8 + 5] = bfhi(w.z); q1[c8 * 8 + 6] = bflo(w.w); q1[c8 * 8 + 7] = bfhi(w.w); }
#pragma unroll
            for (int c8 = 0; c8 < 8; ++c8) { const v4u w = *(const GAS v4u*)(qp + 64 + c8 * 8); q2[c8 * 8 + 0] = bflo(w.x); q2[c8 * 8 + 1] = bfhi(w.x); q2[c8 * 8 + 2] = bflo(w.y); q2[c8 * 8 + 3] = bfhi(w.y); q2[c8 * 8 + 4] = bflo(w.z); q2[c8 * 8 + 5] = bfhi(w.z); q2[c8 * 8 + 6] = bflo(w.w); q2[c8 * 8 + 7] = bfhi(w.w); }
            float o1[16], o2[16]; float m1 = -1e30f, m2 = -1e30f, l1 = 0.f, l2 = 0.f;
#pragma unroll
            for (int j = 0; j < 16; ++j) { o1[j] = 0.f; o2[j] = 0.f; }
            const int nk = 64 * (qc + 1);
            for (int j = 0; j < nk; ++j) {
                const bf16* kp = KB + (rbase + j) * D + h * 128; const bf16* vp = VB + (rbase + j) * D + h * 128 + sl * 16;
                float s1 = 0.f, s2 = 0.f;
#pragma unroll
                for (int c8 = 0; c8 < 8; ++c8) { const v4u w = *(const GAS v4u*)(kp + c8 * 8);
                    s1 += q1[c8 * 8 + 0] * bflo(w.x) + q1[c8 * 8 + 1] * bfhi(w.x) + q1[c8 * 8 + 2] * bflo(w.y) + q1[c8 * 8 + 3] * bfhi(w.y) + q1[c8 * 8 + 4] * bflo(w.z) + q1[c8 * 8 + 5] * bfhi(w.z) + q1[c8 * 8 + 6] * bflo(w.w) + q1[c8 * 8 + 7] * bfhi(w.w); }
#pragma unroll
                for (int c8 = 0; c8 < 8; ++c8) { const v4u w = *(const GAS v4u*)(kp + 64 + c8 * 8);
                    s2 += q2[c8 * 8 + 0] * bflo(w.x) + q2[c8 * 8 + 1] * bfhi(w.x) + q2[c8 * 8 + 2] * bflo(w.y) + q2[c8 * 8 + 3] * bfhi(w.y) + q2[c8 * 8 + 4] * bflo(w.z) + q2[c8 * 8 + 5] * bfhi(w.z) + q2[c8 * 8 + 6] * bflo(w.w) + q2[c8 * 8 + 7] * bfhi(w.w); }
                const v4u v0 = *(const GAS v4u*)vp, v1 = *(const GAS v4u*)(vp + 8);
                const float vv[16] = {bflo(v0.x), bfhi(v0.x), bflo(v0.y), bfhi(v0.y), bflo(v0.z), bfhi(v0.z), bflo(v0.w), bfhi(v0.w), bflo(v1.x), bfhi(v1.x), bflo(v1.y), bfhi(v1.y), bflo(v1.z), bfhi(v1.z), bflo(v1.w), bfhi(v1.w)};
                { const float mn = fmaxf(m1, s1), a = __builtin_amdgcn_exp2f(m1 - mn), p = __builtin_amdgcn_exp2f(s1 - mn); m1 = mn; l1 = l1 * a + p;
#pragma unroll
                  for (int d = 0; d < 16; ++d) o1[d] = o1[d] * a + p * vv[d]; }
                { const float mn = fmaxf(m2, s2), a = __builtin_amdgcn_exp2f(m2 - mn), p = __builtin_amdgcn_exp2f(s2 - mn); m2 = mn; l2 = l2 * a + p;
#pragma unroll
                  for (int d = 0; d < 16; ++d) o2[d] = o2[d] * a + p * vv[d]; }
            }
            const float i1 = 1.0f / l1, i2 = lam / l2; float ss = 0.f;
#pragma unroll
            for (int d = 0; d < 16; ++d) { o1[d] = o1[d] * i1 - o2[d] * i2; ss += o1[d] * o1[d]; }
            ss += __shfl_xor(ss, 1); ss += __shfl_xor(ss, 2); ss += __shfl_xor(ss, 4);
            const float rs = (1.0f - LAM_INIT) / sqrtf(ss * (1.0f / 128.0f) + EPS);
            bf16* op = QB + (rbase + qc * 64 + row) * D + h * 128 + sl * 16;
            unsigned w[8];
#pragma unroll
            for (int d = 0; d < 8; ++d) w[d] = pk2(o1[2 * d] * rs * head_norm[sl * 16 + 2 * d], o1[2 * d + 1] * rs * head_norm[sl * 16 + 2 * d + 1]);
            *(GAS v4u*)op = (v4u){w[0], w[1], w[2], w[3]}; *(GAS v4u*)(op + 8) = (v4u){w[4], w[5], w[6], w[7]};
        }
    }
    SEAM(5);
    if (IN(6)) { EpiGlu e{HB, UB, b_glu}; ngemm(lds, HB, D, Wglu, 1, D, M, D, D, e, vcu, G); }
    SEAM(6);
    if (IN(7)) { EpiMergeA e{GT, (float*)KB}; ngemm(lds, UB, D, Wssm, 1, D, M, D, D, e, vcu, G); }
    SEAM(7);
    if (IN(8)) { EpiMergeB e{GT, (const float*)KB, UB}; ngemm(lds, QB, D, Wda, 1, D, M, D, D, e, vcu, G); }
    SEAM(8);
    if (IN(9)) { EpiStore e{QB, D, 1.0f}; ngemm(lds, UB, D, Wmix, 1, D, M, D, D, e, vcu, G); }
    SEAM(9);
    if (IN(10)) { for (int m = gw; m < M; m += NGW) resnorm_row(QB + (size_t)m * D, x + (size_t)m * D, g_mix_post, out + (size_t)m * D, g_x_pre, HB + (size_t)m * D, lane); }
    SEAM(10);
    if (IN(11)) { EpiStore e{UB, D, XSCALE}; ngemm(lds, HB, D, Wxq, 1, D, M, D, D, e, vcu, G); }
    SEAM(11);
    if (IN(12)) {
        LAS float* qs = (LAS float*)lds; LAS float* Ss = qs + 32 * 256;
        for (int unit = vcu; unit < BATCH * 4 * (SEQ / 32); unit += G) {
            const int rb = unit % (SEQ / 32), hd = (unit / (SEQ / 32)) & 3, b = unit / (4 * (SEQ / 32));
            const size_t r0 = (size_t)b * SEQ + rb * 32;
            for (int idx = tid; idx < 32 * 256; idx += 512) qs[idx] = bf2f(UB[(r0 + (idx >> 8)) * D + hd * 256 + (idx & 255)]);
            __syncthreads();
            const int row = tid >> 4, ks = tid & 15;
            for (int kk = 0; kk < 16; ++kk) {
                const int key = ks + 16 * kk; const bf16* kp = KVM + (size_t)(b * MEML + key) * 2048 + hd * 256;
                float s = 0.f;
                for (int d8 = 0; d8 < 32; ++d8) { const v4u w = *(const GAS v4u*)(kp + d8 * 8); const LAS float* q = qs + row * 256 + d8 * 8;
                    s += q[0] * bflo(w.x) + q[1] * bfhi(w.x) + q[2] * bflo(w.y) + q[3] * bfhi(w.y) + q[4] * bflo(w.z) + q[5] * bfhi(w.z) + q[6] * bflo(w.w) + q[7] * bfhi(w.w); }
                Ss[row * 256 + key] = s;
            }
            __syncthreads();
            { float mx = -1e30f;
              for (int kk = 0; kk < 16; ++kk) mx = fmaxf(mx, Ss[row * 256 + ks + 16 * kk]);
              mx = fmaxf(mx, __shfl_xor(mx, 1)); mx = fmaxf(mx, __shfl_xor(mx, 2)); mx = fmaxf(mx, __shfl_xor(mx, 4)); mx = fmaxf(mx, __shfl_xor(mx, 8));
              float sum = 0.f; float e[16];
#pragma unroll
              for (int kk = 0; kk < 16; ++kk) { e[kk] = __builtin_amdgcn_exp2f(Ss[row * 256 + ks + 16 * kk] - mx); sum += e[kk]; }
              sum += __shfl_xor(sum, 1); sum += __shfl_xor(sum, 2); sum += __shfl_xor(sum, 4); sum += __shfl_xor(sum, 8);
              const float inv = 1.0f / sum;
#pragma unroll
              for (int kk = 0; kk < 16; ++kk) Ss[row * 256 + ks + 16 * kk] = e[kk] * inv; }
            __syncthreads();
            { float o[16];
#pragma unroll
              for (int d = 0; d < 16; ++d) o[d] = 0.f;
              for (int mk = 0; mk < MEML; ++mk) { const float p = Ss[row * 256 + mk]; const bf16* vp = KVM + (size_t)(b * MEML + mk) * 2048 + 1024 + hd * 256 + ks * 16;
                  const v4u v0 = *(const GAS v4u*)vp, v1 = *(const GAS v4u*)(vp + 8);
                  o[0] += p * bflo(v0.x); o[1] += p * bfhi(v0.x); o[2] += p * bflo(v0.y); o[3] += p * bfhi(v0.y); o[4] += p * bflo(v0.z); o[5] += p * bfhi(v0.z); o[6] += p * bflo(v0.w); o[7] += p * bfhi(v0.w);
                  o[8] += p * bflo(v1.x); o[9] += p * bfhi(v1.x); o[10] += p * bflo(v1.y); o[11] += p * bfhi(v1.y); o[12] += p * bflo(v1.z); o[13] += p * bfhi(v1.z); o[14] += p * bflo(v1.w); o[15] += p * bfhi(v1.w); }
              bf16* op = QB + (r0 + row) * D + hd * 256 + ks * 16;
              *(GAS v4u*)op = (v4u){pk2(o[0], o[1]), pk2(o[2], o[3]), pk2(o[4], o[5]), pk2(o[6], o[7])};
              *(GAS v4u*)(op + 8) = (v4u){pk2(o[8], o[9]), pk2(o[10], o[11]), pk2(o[12], o[13]), pk2(o[14], o[15])}; }
            __syncthreads();
        }
    }
    SEAM(12);
    if (IN(13)) { EpiStore e{KB, D, 1.0f}; ngemm(lds, QB, D, Wxo, 1, D, M, D, D, e, vcu, G); }
    SEAM(13);
    if (IN(14)) { for (int m = gw; m < M; m += NGW) resnorm_row(KB + (size_t)m * D, out + (size_t)m * D, g_x_post, out + (size_t)m * D, g_ff_pre, HB + (size_t)m * D, lane); }
    SEAM(14);
    if (IN(15)) { EpiRelu2 e{UB, FF}; ngemm(lds, HB, D, Wf1, 1, D, M, FF, D, e, vcu, G); }
    SEAM(15);
    if (IN(16)) { EpiStore e{HB, D, 1.0f}; ngemm(lds, UB, FF, Wf2, 1, FF, M, D, FF, e, vcu, G); }
    SEAM(16);
    if (IN(17)) { for (int m = gw; m < M; m += NGW) resnorm_row(HB + (size_t)m * D, out + (size_t)m * D, g_ff_post, out + (size_t)m * D, nullptr, nullptr, lane); }
#undef IN
#undef SEAM
}

constexpr int N_PHASES = 18;
extern "C" void kernel_launch(void* const* d_in, const int* in_sizes, int n_in, void* d_out, int out_size, void* d_ws, size_t ws_size, hipStream_t stream) {
    static int grid = 0;
    if (grid == 0) {
        if (n_in != 34 || in_sizes[0] != M * D || out_size != M * D || ws_size < WS_END) { fprintf(stderr, "kernel_launch: unexpected shapes (n_in %d, in0 %d, out %d, ws %zu)\n", n_in, n_in > 0 ? in_sizes[0] : -1, out_size, ws_size); grid = -1; return; }
        int dev = 0, cus = 0, per_cu = 0;
        if (hipGetDevice(&dev) != hipSuccess || hipDeviceGetAttribute(&cus, hipDeviceAttributeMultiprocessorCount, dev) != hipSuccess) { grid = -1; return; }
        if (hipFuncSetAttribute((const void*)mk_fwd, hipFuncAttributeMaxDynamicSharedMemorySize, LDS_BYTES) != hipSuccess) { fprintf(stderr, "kernel_launch: hipFuncSetAttribute failed\n"); grid = -1; return; }
        if (hipOccupancyMaxActiveBlocksPerMultiprocessor(&per_cu, (const void*)mk_fwd, NWAVES * 64, LDS_BYTES) != hipSuccess || per_cu < 1) { fprintf(stderr, "kernel_launch: occupancy query says %d\n", per_cu); per_cu = 1; }
        (void)hipGetLastError();
        grid = cus;
    }
    if (grid < 0) return;
    if (hipMemsetAsync((char*)d_ws + WS_CTL, 0, CTL_ZERO_BYTES, stream) != hipSuccess) return;
    Args a{};
    for (int i = 0; i < 34; ++i) a.in[i] = (const float*)d_in[i];
    a.out = (float*)d_out; a.ws = (unsigned char*)d_ws;
    if (MK_N_LAUNCHES == 1) { a.ph_lo = 0; a.ph_hi = N_PHASES; a.li = 0; hipLaunchKernelGGL(mk_fwd, dim3(grid), dim3(NWAVES * 64), LDS_BYTES, stream, a); }
    else { for (int p = 0; p < N_PHASES; ++p) { a.ph_lo = p; a.ph_hi = p + 1; a.li = p; hipLaunchKernelGGL(mk_fwd, dim3(grid), dim3(NWAVES * 64), LDS_BYTES, stream, a); } }
}
```

```cpp
#include <hip/hip_runtime.h>
#include <cstdio>
#include <cstdint>

#ifndef MK_N_LAUNCHES
#define MK_N_LAUNCHES 1
#endif

#ifndef FAST_MASK
#define FAST_MASK 0x3FF
#endif
#define FAST(k) ((FAST_MASK >> (k)) & 1)
#define GAS __attribute__((address_space(1)))
#define LAS __attribute__((address_space(3)))
typedef unsigned short bf16;
typedef unsigned v4u __attribute__((ext_vector_type(4)));
typedef unsigned v2u __attribute__((ext_vector_type(2)));
typedef float f32x4 __attribute__((ext_vector_type(4)));
typedef GAS unsigned gu32;
#define RLX_AGENT __ATOMIC_RELAXED, __HIP_MEMORY_SCOPE_AGENT
#define LDS_WAIT() asm volatile("s_waitcnt lgkmcnt(0)" ::: "memory")
#define VM_WAIT() asm volatile("s_waitcnt vmcnt(0)" ::: "memory")

constexpr int BATCH = 2, SEQ = 8192, D = 1024, M = BATCH * SEQ, INC = 6144, FF = 4096, MEML = 256, MM = BATCH * MEML;
constexpr int SG = 64, SH = 16, SP = 64;
constexpr int CH = 64, NCH = SEQ / CH;
constexpr float EPS = 1e-6f;
constexpr float LOG2E = 1.4426950408889634f;
constexpr float QSCALE = 0.125f * LOG2E;
constexpr float XSCALE = 0.0625f * LOG2E;
constexpr float LAM_INIT = 0.2f;

constexpr size_t MiB = 1u << 20;
constexpr size_t WS_CTL = 0, CTL_ZERO_BYTES = 64 * 1024;
constexpr size_t WS_SCAL = 64 * 1024;
constexpr size_t WS_SSMP = 128 * 1024;
constexpr size_t WS_COS = 1 * MiB, WS_SIN = 2 * MiB;
constexpr size_t WS_MEMN = 3 * MiB;
constexpr size_t WS_KVM = 4 * MiB;
constexpr size_t WS_WIN = 8 * MiB;
constexpr size_t WS_WGLU = 20 * MiB, WS_WSSM = 22 * MiB, WS_WDA = 24 * MiB, WS_WMIX = 26 * MiB, WS_WXQ = 28 * MiB, WS_WXO = 30 * MiB;
constexpr size_t WS_WXKV = 32 * MiB;
constexpr size_t WS_WF1 = 36 * MiB;
constexpr size_t WS_WF2 = 44 * MiB;
constexpr size_t WS_H = 52 * MiB, WS_U = 84 * MiB, WS_Q = 116 * MiB, WS_K = 148 * MiB, WS_V = 180 * MiB;
constexpr size_t WS_E = 212 * MiB, WS_SIN_C = 220 * MiB;
constexpr size_t WS_END = 228 * MiB;
constexpr int CW_BAR = 1024;

constexpr int RING_BYTES = 131072, LDSCTL_OFF = RING_BYTES, MISC_OFF = LDSCTL_OFF + 320, LDS_BYTES = 147456;
constexpr int NWAVES = 8;

__device__ __forceinline__ unsigned f2bf(float f) { unsigned u = __builtin_bit_cast(unsigned, f); return (u + 0x7fffu + ((u >> 16) & 1u)) >> 16; }
__device__ __forceinline__ unsigned pk2(float lo, float hi) { return f2bf(lo) | (f2bf(hi) << 16); }
__device__ __forceinline__ float bf2f(unsigned short h) { return __builtin_bit_cast(float, (unsigned)h << 16); }
__device__ __forceinline__ float bflo(unsigned w) { return __builtin_bit_cast(float, w << 16); }
__device__ __forceinline__ float bfhi(unsigned w) { return __builtin_bit_cast(float, w & 0xffff0000u); }

#define XB_TMO      128
#define XB_XCNT(j)  (256  + 64 * (j))
#define XB_XSUB(j)  (1280 + 64 * (j))
#define XB_XGEN(j)  (2304 + 64 * (j))
#define XB_TOP      3328
#define XB_TOPGEN   3392
#define XCD_BAR_WORDS 3456
#define XB_SPIN_CAP (1u << 18)
__device__ __forceinline__ unsigned xb_ld(unsigned* p)              { return __hip_atomic_load(p, __ATOMIC_RELAXED, __HIP_MEMORY_SCOPE_AGENT); }
__device__ __forceinline__ unsigned xb_add(unsigned* p, unsigned v) { return __hip_atomic_fetch_add(p, v, __ATOMIC_RELAXED, __HIP_MEMORY_SCOPE_AGENT); }
__device__ __forceinline__ unsigned xb_xcc_id() { return (unsigned)__builtin_amdgcn_s_getreg((3 << 11) | 20) & 0xFu; }
#define XB_SPIN(cond, bar) do { unsigned _sp = 0; while (cond) { __builtin_amdgcn_s_sleep(1); \
    if ((++_sp & 255u) == 0u) { if (xb_ld(&(bar)[XB_TMO])) break; if (_sp > XB_SPIN_CAP) { atomicAdd(&(bar)[XB_TMO], 1u); break; } } } } while (0)
struct XcdBarrier { unsigned* bar; unsigned x; volatile LAS unsigned* st; };
__device__ __forceinline__ XcdBarrier xcd_barrier_post(unsigned* bar, volatile LAS unsigned* st) {
    XcdBarrier b; b.bar = bar; b.x = xb_xcc_id(); b.st = st;
    if (threadIdx.x == 0) (void)xb_add(&bar[XB_XCNT(b.x)], 1u);
    return b;
}
__device__ __forceinline__ void xcd_barrier_complete(unsigned* bar, unsigned x, unsigned& nloc, unsigned& nx) {
    const unsigned G = gridDim.x * gridDim.y * gridDim.z;
    unsigned sum, cnt, mine, sp = 0u;
    for (;;) {
        sum = 0u; cnt = 0u; mine = 0u;
#pragma unroll
        for (unsigned j = 0; j < 16; ++j) { const unsigned c = xb_ld(&bar[XB_XCNT(j)]); sum += c; cnt += (c > 0u) ? 1u : 0u; mine = (j == x) ? c : mine; }
        if (sum == G) break;
        __builtin_amdgcn_s_sleep(1);
        if ((++sp & 255u) == 0u) { if (xb_ld(&bar[XB_TMO])) break; if (sp > XB_SPIN_CAP) { atomicAdd(&bar[XB_TMO], 1u); break; } }
    }
    nloc = mine > 0u ? mine : 1u; nx = cnt > 0u ? cnt : 1u;
}
__device__ __forceinline__ void xcd_barrier(const XcdBarrier& b) {
    asm volatile("s_waitcnt vmcnt(0)" ::: "memory");
    __syncthreads();
    if (threadIdx.x == 0) {
        unsigned* bar = b.bar;
        __builtin_amdgcn_s_waitcnt(0);
        unsigned nloc = b.st[0], nx = b.st[1];
        if (nloc == 0u) { xcd_barrier_complete(bar, b.x, nloc, nx); b.st[0] = nloc; b.st[1] = nx; }
        const unsigned old = xb_add(&bar[XB_XSUB(b.x)], 1u);
        const unsigned gen = old / nloc;
        if (old + 1u == (gen + 1u) * nloc) {
            __builtin_amdgcn_fence(__ATOMIC_RELEASE, "agent");
            asm volatile("s_waitcnt vmcnt(0)" ::: "memory");
            const unsigned og = xb_add(&bar[XB_TOP], 1u);
            const unsigned tg = og / nx;
            if (og + 1u == (tg + 1u) * nx) xb_add(&bar[XB_TOPGEN], 1u);
            else XB_SPIN(xb_ld(&bar[XB_TOPGEN]) == tg, bar);
            __builtin_amdgcn_fence(__ATOMIC_ACQUIRE, "agent");
            xb_add(&bar[XB_XGEN(b.x)], 1u);
            asm volatile("s_waitcnt vmcnt(0)" ::: "memory");
        } else {
            XB_SPIN(xb_ld(&bar[XB_XGEN(b.x)]) == gen, bar);
            __builtin_amdgcn_fence(__ATOMIC_ACQUIRE, "agent");
            asm volatile("s_waitcnt vmcnt(0)" ::: "memory");
        }
    }
    __syncthreads();
}

struct Frame {
    LAS unsigned char* lds;
    int tid, lane, wave, vcu, G;
    const float* const* in;
};
struct Args { const float* in[34]; float* out; unsigned char* ws; int ph_lo, ph_hi, li, pad; };

__device__ __forceinline__ float wave_sum(float v) {
#pragma unroll
    for (int o = 1; o < 64; o <<= 1) v += __shfl_xor(v, o);
    return v;
}

__device__ __forceinline__ int rope_dest(int col) { const int s = col & 127, a = s >> 6, n = (s >> 5) & 1, b = (s >> 4) & 1, rest = s & 15; return (col & ~127) + 64 * a + 32 * b + 8 * (rest >> 2) + 4 * n + (rest & 3); }
template <bool ROPEPERM>
__device__ __forceinline__ void p0_transpose_item(const float* W, int K, int N, bf16* WT, LAS float* scr, int item, int lane) {
    const int nblk = N / 32, kb = item / nblk, nb = item % nblk, k0 = 64 * kb, n0 = 32 * nb;
#pragma unroll 8
    for (int i = 0; i < 32; ++i) { const int kk = 2 * i + (lane >> 5); scr[kk * 33 + (lane & 31)] = W[(size_t)(k0 + kk) * N + n0 + (lane & 31)]; }
    LDS_WAIT(); asm volatile("" ::: "memory");
    const int c = lane & 7;
#pragma unroll
    for (int j = 0; j < 4; ++j) { const int n = (lane >> 3) + 8 * j; const LAS float* s = scr + (8 * c) * 33 + n;
        v4u o; o.x = pk2(s[0 * 33], s[1 * 33]); o.y = pk2(s[2 * 33], s[3 * 33]); o.z = pk2(s[4 * 33], s[5 * 33]); o.w = pk2(s[6 * 33], s[7 * 33]);
        const int drow = (ROPEPERM && (n0 + n) >= 1024 && (n0 + n) < 3072) ? rope_dest(n0 + n) : (n0 + n);
        *(GAS v4u*)(WT + (size_t)drow * K + k0 + 8 * c) = o; }
    LDS_WAIT(); asm volatile("" ::: "memory");
}
__device__ __forceinline__ void rms_row_to_bf16(const float* xrow, const float* g, bf16* orow, int lane) {
    const GAS f32x4* xr = (const GAS f32x4*)xrow + lane; const GAS f32x4* gr = (const GAS f32x4*)g + lane;
    f32x4 v[4]; float s = 0.f;
#pragma unroll
    for (int j = 0; j < 4; ++j) { v[j] = xr[64 * j]; s += (v[j].x * v[j].x + v[j].y * v[j].y) + (v[j].z * v[j].z + v[j].w * v[j].w); }
    const float rs = 1.0f / sqrtf(wave_sum(s) * (1.f / D) + EPS);
    GAS v2u* o8 = (GAS v2u*)orow + lane;
#pragma unroll
    for (int j = 0; j < 4; ++j) { const f32x4 gg = gr[64 * j]; v2u w; w.x = pk2(v[j].x * rs * gg.x, v[j].y * rs * gg.y); w.y = pk2(v[j].z * rs * gg.z, v[j].w * rs * gg.w); o8[64 * j] = w; }
}
__device__ __forceinline__ void resnorm_row(const bf16* yrow, const float* xi, const float* g1, float* xo, const float* g2, bf16* hn, int lane) {
    const GAS v2u* yr = (const GAS v2u*)yrow + lane; const GAS f32x4* xr = (const GAS f32x4*)xi + lane; const GAS f32x4* g1r = (const GAS f32x4*)g1 + lane;
    f32x4 y[4], x[4]; float s = 0.f;
#pragma unroll
    for (int j = 0; j < 4; ++j) { const v2u w = yr[64 * j]; y[j] = (f32x4){bflo(w.x), bfhi(w.x), bflo(w.y), bfhi(w.y)}; x[j] = xr[64 * j];
        s += (y[j].x * y[j].x + y[j].y * y[j].y) + (y[j].z * y[j].z + y[j].w * y[j].w); }
    const float rs = 1.0f / sqrtf(wave_sum(s) * (1.f / D) + EPS);
    float s2 = 0.f;
#pragma unroll
    for (int j = 0; j < 4; ++j) { const f32x4 gg = g1r[64 * j]; x[j] = x[j] + y[j] * rs * gg; s2 += (x[j].x * x[j].x + x[j].y * x[j].y) + (x[j].z * x[j].z + x[j].w * x[j].w); }
    GAS f32x4* xw = (GAS f32x4*)xo + lane;
#pragma unroll
    for (int j = 0; j < 4; ++j) xw[64 * j] = x[j];
    if (hn) {
        const float rs2 = 1.0f / sqrtf(wave_sum(s2) * (1.f / D) + EPS);
        const GAS f32x4* g2r = (const GAS f32x4*)g2 + lane; GAS v2u* o8 = (GAS v2u*)hn + lane;
#pragma unroll
        for (int j = 0; j < 4; ++j) { const f32x4 gg = g2r[64 * j]; v2u w; w.x = pk2(x[j].x * rs2 * gg.x, x[j].y * rs2 * gg.y); w.y = pk2(x[j].z * rs2 * gg.z, x[j].w * rs2 * gg.w); o8[64 * j] = w; }
    }
}

__device__ __forceinline__ double rope_inv(int i) {
    const double r = 0.74989420933245582730218427561514;
    double v = 1.0;
    for (int k = 0; k < i; ++k) v *= r;
    return v;
}
__device__ __forceinline__ void sincos_reduced(double ang, float& c, float& s) {
    const double inv2pi = 0.15915494309189533576888376337251;
    const double twopi = 6.283185307179586476925286766559;
    const double k = __builtin_rint(ang * inv2pi);
    const float r = (float)(ang - k * twopi);
    c = cosf(r); s = sinf(r);
}

namespace pg8 {
#define PG8_LAS __attribute__((address_space(3)))
typedef unsigned short bf16_t;
typedef short bf16x8 __attribute__((ext_vector_type(8)));
typedef float f32x4 __attribute__((ext_vector_type(4)));
typedef unsigned u32x4 __attribute__((ext_vector_type(4)));
constexpr int BM = 256, BK = 64, HALF = 128, HTB = HALF * BK * 2  , STAGE_BYTES = 8 * HTB, NXCD = 8, WGM = 8;

__host__ __device__ __forceinline__ int lds_byte(int r, int c) { const int st = (r >> 4) * 2 + (c >> 5), rr = r & 15, cc = c & 31, ob = rr * 64 + cc * 2; return st * 1024 + (ob ^ (((ob >> 9) & 1) << 5)); }
__host__ __device__ __forceinline__ void stage_rc(int b, int& R, int& C) { const int st = b / 1024, sb = b % 1024, swz = sb ^ (((sb >> 9) & 1) << 5); R = (st >> 1) * 16 + swz / 64; C = (st & 1) * 32 + (swz % 64) / 2; }
__host__ __device__ __forceinline__ int perm32(int rho) { const int n = rho >> 4, i = rho & 15; return 8 * (i >> 2) + 4 * n + (i & 3); }

struct Unit { int pm, pn; };
struct Gemm { const bf16_t* A; const bf16_t* Bt; int M, N, K; };

struct StaticOrder {
    int nM, nN, nwg, G, c;
    __host__ __device__ void init(int M, int N, int G_, int c_) { nM = M / BM; nN = N / BM; nwg = nM * nN; G = G_; c = c_; }
    __host__ __device__ bool next(int i, Unit& u) const {
        const long L = (long)i * G + c; if (L >= nwg) return false;
        int wgid = (int)L; { const int q = nwg / NXCD, r = nwg % NXCD, xcd = wgid % NXCD, off = wgid / NXCD; wgid = (xcd < r ? xcd * (q + 1) : r * (q + 1) + (xcd - r) * q) + off; }
        const int nig = WGM * nN, gid = wgid / nig, fm = gid * WGM, gsz = (nM - fm) < WGM ? (nM - fm) : WGM;
        u.pm = fm + ((wgid % nig) % gsz); u.pn = (wgid % nig) / gsz; return true;
    }
    __device__ __forceinline__ void a_ready(const Unit&) const {}
    __device__ __forceinline__ void done(const Unit&) const {}
};


typedef float cvt_f32x2 __attribute__((ext_vector_type(2))); typedef __bf16 cvt_bf16x2 __attribute__((ext_vector_type(2)));
__device__ __forceinline__ unsigned cvt_pk_bf16(float lo, float hi) { cvt_f32x2 v = {lo, hi}; cvt_bf16x2 b = __builtin_convertvector(v, cvt_bf16x2); return __builtin_bit_cast(unsigned, b); }
typedef unsigned u32x2 __attribute__((ext_vector_type(2)));
__device__ __forceinline__ float fsigmoid(float v) { return __builtin_amdgcn_rcpf(1.0f + __builtin_amdgcn_exp2f(-1.4426950408889634f * v)); }
__device__ __forceinline__ f32x4 sig4(f32x4 v) { return (f32x4){fsigmoid(v[0]), fsigmoid(v[1]), fsigmoid(v[2]), fsigmoid(v[3])}; }
__device__ __forceinline__ f32x4 bf4(unsigned lo, unsigned hi) { return (f32x4){__builtin_bit_cast(float, lo << 16), __builtin_bit_cast(float, lo & 0xffff0000u), __builtin_bit_cast(float, hi << 16), __builtin_bit_cast(float, hi & 0xffff0000u)}; }

template <int ACT  > struct EpiBf16 {
    static constexpr bool PERM = true, AFTER_DRAIN = false;
    bf16_t* O; int ldc; float scale;
    __device__ __forceinline__ void operator()(const f32x4 (&acc)[2][2][4][2], const Unit& u, int wr, int wc, int fr, int fq) const {
        const int row0 = u.pm * BM + wr * 64 + fr, col0 = u.pn * BM + wc * 32 + 8 * fq;
#pragma unroll
        for (int ai = 0; ai < 2; ++ai)
#pragma unroll
            for (int m = 0; m < 4; ++m) { bf16_t* rowp = O + (size_t)(row0 + ai * HALF + m * 16) * ldc + col0;
#pragma unroll
                for (int bj = 0; bj < 2; ++bj) { f32x4 v0 = acc[ai][bj][m][0], v1 = acc[ai][bj][m][1];
                    if (ACT == 2) { v0 = __builtin_elementwise_max(v0, (f32x4){0.f, 0.f, 0.f, 0.f}); v1 = __builtin_elementwise_max(v1, (f32x4){0.f, 0.f, 0.f, 0.f}); v0 = v0 * v0; v1 = v1 * v1; }
                    else { v0 = v0 * scale; v1 = v1 * scale; }
                    u32x4 w; w.x = cvt_pk_bf16(v0[0], v0[1]); w.y = cvt_pk_bf16(v0[2], v0[3]); w.z = cvt_pk_bf16(v1[0], v1[1]); w.w = cvt_pk_bf16(v1[2], v1[3]);
                    *(u32x4*)(rowp + bj * HALF) = w; } }
    }
};
struct EpiInProjF {
    static constexpr bool PERM = true, AFTER_DRAIN = false;
    bf16_t *U, *Q, *K, *V, *Gt; const float *cosT, *sinT, *bgate; float qscale;
    __device__ __forceinline__ void operator()(const f32x4 (&acc)[2][2][4][2], const Unit& u, int wr, int wc, int fr, int fq) const {
        const int row0 = u.pm * BM + wr * 64 + fr, pn = u.pn;
        if (pn >= 4 && pn < 12) {
            bf16_t* dst = (pn < 8) ? Q : K; const float sc = (pn < 8) ? qscale : 1.0f;
            const int i0 = 16 * (wc & 1) + 4 * fq, cbase = (pn & 3) * 256 + 64 * (wc >> 1) + i0;
#pragma unroll
            for (int ai = 0; ai < 2; ++ai)
#pragma unroll
                for (int m = 0; m < 4; ++m) { const int row = row0 + ai * HALF + m * 16, pos = row & 8191;
                    const f32x4 cs = *(const f32x4*)(cosT + pos * 32 + i0) * sc, sn = *(const f32x4*)(sinT + pos * 32 + i0) * sc;
                    bf16_t* rowp = dst + (size_t)row * 1024 + cbase;
#pragma unroll
                    for (int bj = 0; bj < 2; ++bj) { const f32x4 t1 = acc[ai][bj][m][0], t2 = acc[ai][bj][m][1];
                        const f32x4 o1 = t1 * cs - t2 * sn, o2 = t2 * cs + t1 * sn;
                        u32x2 w1, w2; w1.x = cvt_pk_bf16(o1[0], o1[1]); w1.y = cvt_pk_bf16(o1[2], o1[3]); w2.x = cvt_pk_bf16(o2[0], o2[1]); w2.y = cvt_pk_bf16(o2[2], o2[3]);
                        *(u32x2*)(rowp + bj * HALF) = w1; *(u32x2*)(rowp + bj * HALF + 32) = w2; } }
        } else if (pn >= 16) {
            const int col0 = (pn - 16) * 256 + wc * 32 + 8 * fq;
            f32x4 bv[2][2];
#pragma unroll
            for (int bj = 0; bj < 2; ++bj)
#pragma unroll
                for (int n = 0; n < 2; ++n) bv[bj][n] = *(const f32x4*)(bgate + col0 + bj * HALF + 4 * n);
#pragma unroll
            for (int ai = 0; ai < 2; ++ai)
#pragma unroll
                for (int m = 0; m < 4; ++m) { bf16_t* rowp = Gt + (size_t)(row0 + ai * HALF + m * 16) * 2048 + col0;
#pragma unroll
                    for (int bj = 0; bj < 2; ++bj) { const f32x4 v0 = sig4(acc[ai][bj][m][0] + bv[bj][0]), v1 = sig4(acc[ai][bj][m][1] + bv[bj][1]);
                        u32x4 w; w.x = cvt_pk_bf16(v0[0], v0[1]); w.y = cvt_pk_bf16(v0[2], v0[3]); w.z = cvt_pk_bf16(v1[0], v1[1]); w.w = cvt_pk_bf16(v1[2], v1[3]);
                        *(u32x4*)(rowp + bj * HALF) = w; } }
        } else {
            bf16_t* dst = (pn < 4) ? U : V; const int col0 = (pn & 3) * 256 + wc * 32 + 8 * fq;
#pragma unroll
            for (int ai = 0; ai < 2; ++ai)
#pragma unroll
                for (int m = 0; m < 4; ++m) { bf16_t* rowp = dst + (size_t)(row0 + ai * HALF + m * 16) * 1024 + col0;
#pragma unroll
                    for (int bj = 0; bj < 2; ++bj) { const f32x4 v0 = acc[ai][bj][m][0], v1 = acc[ai][bj][m][1];
                        u32x4 w; w.x = cvt_pk_bf16(v0[0], v0[1]); w.y = cvt_pk_bf16(v0[2], v0[3]); w.z = cvt_pk_bf16(v1[0], v1[1]); w.w = cvt_pk_bf16(v1[2], v1[3]);
                        *(u32x4*)(rowp + bj * HALF) = w; } }
        }
    }
};
struct EpiGluF {
    static constexpr bool PERM = true, AFTER_DRAIN = false;
    const bf16_t* YS; bf16_t* O; const float* bglu;
    __device__ __forceinline__ void operator()(const f32x4 (&acc)[2][2][4][2], const Unit& u, int wr, int wc, int fr, int fq) const {
        const int row0 = u.pm * BM + wr * 64 + fr, col0 = u.pn * BM + wc * 32 + 8 * fq;
        f32x4 bv[2][2];
#pragma unroll
        for (int bj = 0; bj < 2; ++bj)
#pragma unroll
            for (int n = 0; n < 2; ++n) bv[bj][n] = *(const f32x4*)(bglu + col0 + bj * HALF + 4 * n);
#pragma unroll
        for (int ai = 0; ai < 2; ++ai)
#pragma unroll
            for (int m = 0; m < 4; ++m) { const size_t off = (size_t)(row0 + ai * HALF + m * 16) * 1024 + col0;
#pragma unroll
                for (int bj = 0; bj < 2; ++bj) { const u32x4 yw = *(const u32x4*)(YS + off + bj * HALF);
                    const f32x4 v0 = bf4(yw.x, yw.y) * sig4(acc[ai][bj][m][0] + bv[bj][0]), v1 = bf4(yw.z, yw.w) * sig4(acc[ai][bj][m][1] + bv[bj][1]);
                    u32x4 w; w.x = cvt_pk_bf16(v0[0], v0[1]); w.y = cvt_pk_bf16(v0[2], v0[3]); w.z = cvt_pk_bf16(v1[0], v1[1]); w.w = cvt_pk_bf16(v1[2], v1[3]);
                    *(u32x4*)(O + off + bj * HALF) = w; } }
    }
};
struct EpiMergeAF {
    static constexpr bool PERM = true, AFTER_DRAIN = false;
    const bf16_t* Gt; float* TMP;
    __device__ __forceinline__ void operator()(const f32x4 (&acc)[2][2][4][2], const Unit& u, int wr, int wc, int fr, int fq) const {
        const int row0 = u.pm * BM + wr * 64 + fr, col0 = u.pn * BM + wc * 32 + 8 * fq;
#pragma unroll
        for (int ai = 0; ai < 2; ++ai)
#pragma unroll
            for (int m = 0; m < 4; ++m) { const size_t row = (size_t)(row0 + ai * HALF + m * 16);
#pragma unroll
                for (int bj = 0; bj < 2; ++bj) { const u32x4 gw = *(const u32x4*)(Gt + row * 2048 + col0 + bj * HALF);
                    float* tp = TMP + row * 1024 + col0 + bj * HALF;
                    *(f32x4*)tp = bf4(gw.x, gw.y) * acc[ai][bj][m][0]; *(f32x4*)(tp + 4) = bf4(gw.z, gw.w) * acc[ai][bj][m][1]; } }
    }
};
struct EpiMergeBF {
    static constexpr bool PERM = true, AFTER_DRAIN = false;
    const bf16_t* Gt; const float* TMP; bf16_t* O;
    __device__ __forceinline__ void operator()(const f32x4 (&acc)[2][2][4][2], const Unit& u, int wr, int wc, int fr, int fq) const {
        const int row0 = u.pm * BM + wr * 64 + fr, col0 = u.pn * BM + wc * 32 + 8 * fq;
#pragma unroll
        for (int ai = 0; ai < 2; ++ai)
#pragma unroll
            for (int m = 0; m < 4; ++m) { const size_t row = (size_t)(row0 + ai * HALF + m * 16);
#pragma unroll
                for (int bj = 0; bj < 2; ++bj) { const u32x4 gw = *(const u32x4*)(Gt + row * 2048 + 1024 + col0 + bj * HALF);
                    const float* tp = TMP + row * 1024 + col0 + bj * HALF;
                    const f32x4 v0 = *(const f32x4*)tp + bf4(gw.x, gw.y) * acc[ai][bj][m][0], v1 = *(const f32x4*)(tp + 4) + bf4(gw.z, gw.w) * acc[ai][bj][m][1];
                    u32x4 w; w.x = cvt_pk_bf16(v0[0], v0[1]); w.y = cvt_pk_bf16(v0[2], v0[3]); w.z = cvt_pk_bf16(v1[0], v1[1]); w.w = cvt_pk_bf16(v1[2], v1[3]);
                    *(u32x4*)(O + row * 1024 + col0 + bj * HALF) = w; } }
    }
};
template <class Epi, class Sched, bool ALIGN_EPI = false, bool SP2 = false>
__device__ __forceinline__ void gemm_phase(PG8_LAS unsigned char* lds, const Gemm g, const Sched& S, const Epi& E) {
    const int tid = threadIdx.x, wid = __builtin_amdgcn_readfirstlane(tid >> 6), lane = tid & 63, wr = wid >> 2, wc = wid & 3, fr = lane & 15, fq = lane >> 4;
    const int K = g.K, nt = K / BK;
    unsigned voffA[2], voffB[2];
#pragma unroll
    for (int i = 0; i < 2; ++i) { int R, C; stage_rc(tid * 16 + i * 8192, R, C); const int Rb = Epi::PERM ? ((R & ~31) + perm32(R & 31)) : R;
        voffA[i] = (unsigned)(R * K + C) * 2u; voffB[i] = (unsigned)(Rb * K + C) * 2u; }
    const size_t kstep = (size_t)(BK * 2);
    const size_t hstep = (size_t)HALF * K * 2;
    const size_t tstep = 2 * hstep;
    const unsigned ldsw = (unsigned)wid * 1024u;
    const int aoff = lds_byte(wr * 64 + fr, fq * 8), boff = lds_byte(wc * 32 + fr, fq * 8);
#define PG8_SA(b, h) (((b) * 2 + (h)) * HTB)
#define PG8_SB(b, h) ((4 + (b) * 2 + (h)) * HTB)
#define PG8_STAGE(bufoff, gbase, voff) do { _Pragma("unroll") for (int _i = 0; _i < 2; ++_i) \
        __builtin_amdgcn_global_load_lds((const unsigned*)((const char*)(gbase) + (voff)[_i]), (PG8_LAS unsigned*)(lds + (bufoff) + ldsw + _i * 8192), 16, 0, 0); } while (0)
#define PG8_LDA(dst, b, h) do { _Pragma("unroll") for (int m = 0; m < 4; ++m) _Pragma("unroll") for (int k = 0; k < 2; ++k) dst[m][k] = *(const PG8_LAS bf16x8*)(lds + PG8_SA(b, h) + aoff + m * 2048 + k * 1024); } while (0)
#define PG8_LDB(dst, b, h) do { _Pragma("unroll") for (int n = 0; n < 2; ++n) _Pragma("unroll") for (int k = 0; k < 2; ++k) dst[n][k] = *(const PG8_LAS bf16x8*)(lds + PG8_SB(b, h) + boff + n * 2048 + k * 1024); } while (0)
#define PG8_MMA(ai, bj, At, Bt) do { __builtin_amdgcn_s_setprio(1); _Pragma("unroll") for (int m = 0; m < 4; ++m) _Pragma("unroll") for (int n = 0; n < 2; ++n) _Pragma("unroll") for (int k = 0; k < 2; ++k) \
        acc[ai][bj][m][n] = __builtin_amdgcn_mfma_f32_16x16x32_bf16(Bt[n][k], At[m][k], acc[ai][bj][m][n], 0, 0, 0); __builtin_amdgcn_s_setprio(0); } while (0)
#define PG8_WAIT_V(n) asm volatile("s_waitcnt vmcnt(" #n ")" ::: "memory")
#define PG8_WAIT_L(n) asm volatile("s_waitcnt lgkmcnt(" #n ")" ::: "memory")
#define PG8_BAR __builtin_amdgcn_s_barrier()
#define PG8_SCHED __builtin_amdgcn_sched_barrier(0)
    Unit cur, nxt; int ui = 0;
    if (!S.next(0, cur)) return;
    f32x4 acc[2][2][4][2];
#pragma unroll
    for (int a = 0; a < 2; ++a)
#pragma unroll
        for (int b = 0; b < 2; ++b)
#pragma unroll
            for (int m = 0; m < 4; ++m)
#pragma unroll
                for (int n = 0; n < 2; ++n) acc[a][b][m][n] = (f32x4){0.f, 0.f, 0.f, 0.f};
    bf16x8 At[4][2], B0[2][2], B1[2][2];
    const char* cA = (const char*)g.A + (size_t)cur.pm * tstep; const char* cB = (const char*)g.Bt + (size_t)cur.pn * tstep;
    S.a_ready(cur);
    if constexpr (SP2) {
        PG8_STAGE(PG8_SB(0, 0), cB, voffB); PG8_STAGE(PG8_SB(0, 1), cB + hstep, voffB); PG8_STAGE(PG8_SA(0, 0), cA, voffA); PG8_STAGE(PG8_SA(0, 1), cA + hstep, voffA);
        if (wr == 1) PG8_BAR;
        PG8_WAIT_V(2); PG8_BAR;
        PG8_STAGE(PG8_SB(1, 0), cB + kstep, voffB); PG8_STAGE(PG8_SA(1, 0), cA + kstep, voffA); PG8_STAGE(PG8_SB(1, 1), cB + hstep + kstep, voffB);
        PG8_WAIT_V(6); PG8_BAR;
    } else {
        PG8_STAGE(PG8_SB(0, 0), cB, voffB); PG8_STAGE(PG8_SA(0, 0), cA, voffA); PG8_STAGE(PG8_SB(0, 1), cB + hstep, voffB); PG8_STAGE(PG8_SA(0, 1), cA + hstep, voffA);
        if (wr == 1) PG8_BAR;
        PG8_WAIT_V(4); PG8_BAR;
        PG8_STAGE(PG8_SB(1, 0), cB + kstep, voffB); PG8_STAGE(PG8_SA(1, 0), cA + kstep, voffA); PG8_STAGE(PG8_SB(1, 1), cB + hstep + kstep, voffB);
        PG8_WAIT_V(6); PG8_BAR;
    }
    for (;;) {
        const bool has_next = S.next(ui + 1, nxt);
        const char* nA = has_next ? (const char*)g.A + (size_t)nxt.pm * tstep : cA; const char* nB = has_next ? (const char*)g.Bt + (size_t)nxt.pn * tstep : cB;
        for (int t = 0; t < nt; t += 2) {
            const bool last = (t == nt - 2);
            const char* a1 = cA + (size_t)(t + 1) * kstep;
            const char* a2 = last ? nA : cA + (size_t)(t + 2) * kstep; const char* b2 = last ? nB : cB + (size_t)(t + 2) * kstep;
            const char* a3 = a2 + kstep; const char* b3 = b2 + kstep;
            if (last && has_next) S.a_ready(nxt);
            if constexpr (SP2) {
            PG8_LDB(B0, 0, 0); PG8_LDB(B1, 0, 1); PG8_SCHED; PG8_LDA(At, 0, 0); PG8_STAGE(PG8_SA(1, 1), a1 + hstep, voffA);
            PG8_WAIT_V(8); PG8_WAIT_L(0); PG8_BAR; PG8_MMA(0, 0, At, B0); PG8_MMA(0, 1, At, B1); PG8_BAR; PG8_SCHED;
            PG8_LDA(At, 0, 1); PG8_STAGE(PG8_SB(0, 0), b2, voffB); PG8_STAGE(PG8_SB(0, 1), b2 + hstep, voffB); PG8_STAGE(PG8_SA(0, 0), a2, voffA);
            PG8_WAIT_V(8); PG8_WAIT_L(0); PG8_BAR; PG8_MMA(1, 0, At, B0); PG8_MMA(1, 1, At, B1); PG8_BAR; PG8_SCHED;
            PG8_LDB(B0, 1, 0); PG8_LDB(B1, 1, 1); PG8_SCHED; PG8_LDA(At, 1, 0); PG8_STAGE(PG8_SA(0, 1), a2 + hstep, voffA);
            PG8_WAIT_V(8); PG8_WAIT_L(0); PG8_BAR; PG8_MMA(0, 0, At, B0); PG8_MMA(0, 1, At, B1); PG8_BAR; PG8_SCHED;
            PG8_LDA(At, 1, 1); PG8_STAGE(PG8_SB(1, 0), b3, voffB); PG8_STAGE(PG8_SB(1, 1), b3 + hstep, voffB); PG8_STAGE(PG8_SA(1, 0), a3, voffA);
            PG8_WAIT_V(8); PG8_WAIT_L(0); PG8_BAR; PG8_MMA(1, 0, At, B0); PG8_MMA(1, 1, At, B1); PG8_BAR; PG8_SCHED;
            } else {
            PG8_LDB(B0, 0, 0); PG8_SCHED; PG8_LDA(At, 0, 0); PG8_STAGE(PG8_SA(1, 1), a1 + hstep, voffA);
            PG8_WAIT_L(8); PG8_BAR; PG8_WAIT_L(0); PG8_MMA(0, 0, At, B0); PG8_BAR; PG8_SCHED;
            PG8_LDB(B1, 0, 1); PG8_STAGE(PG8_SB(0, 0), b2, voffB);
            PG8_BAR; PG8_WAIT_L(0); PG8_MMA(0, 1, At, B1); PG8_BAR;
            PG8_LDA(At, 0, 1); PG8_STAGE(PG8_SA(0, 0), a2, voffA);
            PG8_BAR; PG8_WAIT_L(0); PG8_MMA(1, 0, At, B0); PG8_BAR; PG8_SCHED;
            PG8_STAGE(PG8_SB(0, 1), b2 + hstep, voffB);
            PG8_WAIT_V(6); PG8_BAR; PG8_MMA(1, 1, At, B1); PG8_BAR;
            PG8_LDB(B0, 1, 0); PG8_SCHED; PG8_LDA(At, 1, 0); PG8_STAGE(PG8_SA(0, 1), a2 + hstep, voffA);
            PG8_WAIT_L(8); PG8_BAR; PG8_WAIT_L(0); PG8_MMA(0, 0, At, B0); PG8_BAR; PG8_SCHED;
            PG8_LDB(B1, 1, 1); PG8_STAGE(PG8_SB(1, 0), b3, voffB);
            PG8_BAR; PG8_WAIT_L(0); PG8_MMA(0, 1, At, B1); PG8_BAR;
            PG8_LDA(At, 1, 1); PG8_STAGE(PG8_SA(1, 0), a3, voffA);
            PG8_BAR; PG8_WAIT_L(0); PG8_MMA(1, 0, At, B0); PG8_BAR; PG8_SCHED;
            PG8_STAGE(PG8_SB(1, 1), b3 + hstep, voffB);
            PG8_WAIT_V(6); PG8_BAR; PG8_MMA(1, 1, At, B1); PG8_BAR;
            }
        }
        if constexpr (ALIGN_EPI) { if (wr == 0) PG8_BAR; }
        if constexpr (!Epi::AFTER_DRAIN) { E(acc, cur, wr, wc, fr, fq); S.done(cur); }
        if (!has_next) break;
#pragma unroll
        for (int a = 0; a < 2; ++a)
#pragma unroll
            for (int b = 0; b < 2; ++b)
#pragma unroll
                for (int m = 0; m < 4; ++m)
#pragma unroll
                    for (int n = 0; n < 2; ++n) acc[a][b][m][n] = (f32x4){0.f, 0.f, 0.f, 0.f};
        cur = nxt; cA = nA; cB = nB; ++ui;
        if constexpr (ALIGN_EPI) { if (wr == 1) PG8_BAR; }
    }
    PG8_WAIT_V(0);
    if constexpr (!ALIGN_EPI) { if (wr == 0) PG8_BAR; }
    PG8_BAR;
    if constexpr (Epi::AFTER_DRAIN) { E.fused(acc, cur, wr, wc, fr, fq, lds, wid, lane); S.done(cur); }
#undef PG8_SA
#undef PG8_SB
#undef PG8_STAGE
#undef PG8_LDA
#undef PG8_LDB
#undef PG8_MMA
#undef PG8_WAIT_V
#undef PG8_WAIT_L
#undef PG8_BAR
#undef PG8_SCHED
}
}

constexpr int NG_LD = 132, NG_TLD = 129;
template <class Epi>
__device__ __forceinline__ void ngemm(LAS unsigned char* lds, const bf16* A, int lda, const bf16* B, int sbk, int sbn, int Mr, int Nc, int Kd, const Epi& epi, int vcu, int G) {
    LAS float* As = (LAS float*)lds; LAS float* Bs = As + 16 * NG_LD; LAS float* T = Bs + 16 * NG_LD;
    const int tid = threadIdx.x, ty = tid >> 4, tx = tid & 15;
    const int nTn = Nc / 128, nT = (Mr / 128) * nTn;
    for (int tile = vcu; tile < nT; tile += G) {
        const int tm = tile / nTn, tn = tile % nTn;
        float acc[4][8];
#pragma unroll
        for (int i = 0; i < 4; ++i)
#pragma unroll
            for (int j = 0; j < 8; ++j) acc[i][j] = 0.f;
        const int lr = tid >> 2, lk = (tid & 3) * 4;
        for (int k0 = 0; k0 < Kd; k0 += 16) {
            { const bf16* ap = A + (size_t)(tm * 128 + lr) * lda + k0 + lk;
#pragma unroll
              for (int j = 0; j < 4; ++j) As[(lk + j) * NG_LD + lr] = bf2f(ap[j]); }
            { const bf16* bp = B + (size_t)(k0 + lk) * sbk + (size_t)(tn * 128 + lr) * sbn;
#pragma unroll
              for (int j = 0; j < 4; ++j) Bs[(lk + j) * NG_LD + lr] = bf2f(bp[(size_t)j * sbk]); }
            __syncthreads();
#pragma unroll
            for (int kk = 0; kk < 16; ++kk) {
                const f32x4 a = *(const LAS f32x4*)(As + kk * NG_LD + ty * 4);
                const f32x4 b0 = *(const LAS f32x4*)(Bs + kk * NG_LD + tx * 8), b1 = *(const LAS f32x4*)(Bs + kk * NG_LD + tx * 8 + 4);
#pragma unroll
                for (int i = 0; i < 4; ++i) {
#pragma unroll
                    for (int j = 0; j < 4; ++j) { acc[i][j] += a[i] * b0[j]; acc[i][4 + j] += a[i] * b1[j]; }
                }
            }
            __syncthreads();
        }
#pragma unroll
        for (int i = 0; i < 4; ++i)
#pragma unroll
            for (int j = 0; j < 8; ++j) T[(ty * 4 + i) * NG_TLD + tx * 8 + j] = acc[i][j];
        __syncthreads();
        for (int idx = tid; idx < 128 * 128; idx += 512) { const int r = idx >> 7, c = idx & 127; epi(tm * 128 + r, tn * 128 + c, T, r, c); }
        __syncthreads();
    }
}
__device__ __forceinline__ float sigmoidf_(float v) { return 1.0f / (1.0f + __expf(-v)); }
__device__ __forceinline__ float gelu_tanh(float x) { const float u = 0.7978845608028654f * (x + 0.044715f * x * x * x); return x / (1.0f + __expf(-2.0f * u)); }

struct EpiStore { bf16* O; int ld; float scale;
    __device__ __forceinline__ void operator()(int row, int col, const LAS float* T, int r, int c) const { O[(size_t)row * ld + col] = (bf16)f2bf(T[r * NG_TLD + c] * scale); } };
struct EpiStoreF32 { float* O; int ld;
    __device__ __forceinline__ void operator()(int row, int col, const LAS float* T, int r, int c) const { O[(size_t)row * ld + col] = T[r * NG_TLD + c]; } };
struct EpiInProj { bf16 *U, *Q, *K, *V, *Gt; const float *cosT, *sinT, *bgate;
    __device__ __forceinline__ void operator()(int row, int col, const LAS float* T, int r, int c) const {
        const float v = T[r * NG_TLD + c];
        if (col < 1024) { U[(size_t)row * D + col] = (bf16)f2bf(v); return; }
        if (col < 3072) { const int cc = (col - 1024) & 1023, d = cc & 63, i = d & 31, pos = row & (SEQ - 1);
            const float cs = cosT[pos * 32 + i], sn = sinT[pos * 32 + i];
            const float o = (d < 32) ? (v * cs - T[r * NG_TLD + c + 32] * sn) : (v * cs + T[r * NG_TLD + c - 32] * sn);
            if (col < 2048) Q[(size_t)row * D + cc] = (bf16)f2bf(o * QSCALE); else K[(size_t)row * D + cc] = (bf16)f2bf(o);
            return; }
        if (col < 4096) { V[(size_t)row * D + (col - 3072)] = (bf16)f2bf(v); return; }
        Gt[(size_t)row * 2048 + (col - 4096)] = (bf16)f2bf(sigmoidf_(v + bgate[col - 4096]));
    } };
struct EpiGlu { const bf16* YS; bf16* O; const float* bglu;
    __device__ __forceinline__ void operator()(int row, int col, const LAS float* T, int r, int c) const {
        const float t = T[r * NG_TLD + c] + bglu[col]; const float ys = bf2f(YS[(size_t)row * D + col]);
        O[(size_t)row * D + col] = (bf16)f2bf(ys * sigmoidf_(t)); } };
struct EpiMergeA { const bf16* Gt; float* TMP;
    __device__ __forceinline__ void operator()(int row, int col, const LAS float* T, int r, int c) const {
        TMP[(size_t)row * D + col] = bf2f(Gt[(size_t)row * 2048 + col]) * T[r * NG_TLD + c]; } };
struct EpiMergeB { const bf16* Gt; const float* TMP; bf16* O;
    __device__ __forceinline__ void operator()(int row, int col, const LAS float* T, int r, int c) const {
        O[(size_t)row * D + col] = (bf16)f2bf(TMP[(size_t)row * D + col] + bf2f(Gt[(size_t)row * 2048 + 1024 + col]) * T[r * NG_TLD + c]); } };
struct EpiGateN { bf16* Gt; const float* bgate;
    __device__ __forceinline__ void operator()(int row, int col, const LAS float* T, int r, int c) const { Gt[(size_t)row * 2048 + col] = (bf16)f2bf(sigmoidf_(T[r * NG_TLD + c] + bgate[col])); } };
struct EpiRelu2 { bf16* O; int ld;
    __device__ __forceinline__ void operator()(int row, int col, const LAS float* T, int r, int c) const { const float v = fmaxf(T[r * NG_TLD + c], 0.f); O[(size_t)row * ld + col] = (bf16)f2bf(v * v); } };

typedef const __attribute__((address_space(4))) Args* KArgP;
__device__ __forceinline__ KArgP late_args() { KArgP p = (KArgP)__builtin_amdgcn_kernarg_segment_ptr(); asm volatile("" : "+s"(p)); return p; }
#define INP(k) ((const float*)late_args()->in[k])
__global__ void __launch_bounds__(NWAVES * 64, 2) mk_fwd(Args args) {
    extern __shared__ __attribute__((aligned(16))) unsigned char lds_raw[];
    LAS unsigned char* lds = (LAS unsigned char*)lds_raw;
    volatile LAS unsigned* MISC = (volatile LAS unsigned*)(lds + MISC_OFF);
    const int tid = threadIdx.x, lane = tid & 63, wave = __builtin_amdgcn_readfirstlane(tid >> 6);
    const int G = gridDim.x; const int bx = blockIdx.x; const int vcu = (G % 8 == 0) ? (bx % 8) * (G / 8) + bx / 8 : bx;
    unsigned char* ws = args.ws;
    gu32* ctl = (gu32*)(ws + WS_CTL);
    for (int u = tid; u < (LDS_BYTES - LDSCTL_OFF) / 4; u += NWAVES * 64) ((LAS unsigned*)(lds + LDSCTL_OFF))[u] = 0u;
    __syncthreads();
    XcdBarrier bar; bar.bar = (unsigned*)(ctl + CW_BAR); bar.x = 0; bar.st = nullptr;
    if (MK_N_LAUNCHES == 1) bar = xcd_barrier_post((unsigned*)(ctl + CW_BAR), MISC + 8);
    const int lo = args.ph_lo, hi = args.ph_hi;
#define IN(k) (lo <= (k) && (k) < hi)
#define SEAM(k) do { if (IN(k) && IN((k) + 1)) xcd_barrier(bar); } while (0)

    float* out = late_args()->out;
    float* scal = (float*)(ws + WS_SCAL); float* lamb = (float*)(ws + WS_SSMP); float* bbar = lamb + SG * SP * 4;
    float* cosT = (float*)(ws + WS_COS); float* sinT = (float*)(ws + WS_SIN);
    bf16* MEMN = (bf16*)(ws + WS_MEMN); bf16* KVM = (bf16*)(ws + WS_KVM);
    bf16* Win = (bf16*)(ws + WS_WIN); bf16* Wglu = (bf16*)(ws + WS_WGLU); bf16* Wssm = (bf16*)(ws + WS_WSSM); bf16* Wda = (bf16*)(ws + WS_WDA); bf16* Wmix = (bf16*)(ws + WS_WMIX);
    bf16* Wxq = (bf16*)(ws + WS_WXQ); bf16* Wxo = (bf16*)(ws + WS_WXO); bf16* Wxkv = (bf16*)(ws + WS_WXKV); bf16* Wf1 = (bf16*)(ws + WS_WF1); bf16* Wf2 = (bf16*)(ws + WS_WF2);
    bf16* HB = (bf16*)(ws + WS_H); bf16* UB = (bf16*)(ws + WS_U); bf16* QB = (bf16*)(ws + WS_Q); bf16* KB = (bf16*)(ws + WS_K); bf16* VB = (bf16*)(ws + WS_V);
    bf16* GT = (bf16*)out;
    float* EB = (float*)(ws + WS_E); float* SINB = (float*)(ws + WS_SIN_C);
    const int gw = vcu * NWAVES + wave, NGW = G * NWAVES;

    if (IN(0)) { const float* x = INP(0); const float* mem = INP(1); const float* g_mix_pre = INP(2); const float* w_in = INP(3); const float* lam_re = INP(5); const float* lam_im = INP(6); const float* log_dt = INP(7); const float* sb_re = INP(8); const float* sb_im = INP(9); const float* w_glu = INP(13); const float* w_ssm = INP(15); const float* lq1 = INP(16); const float* lk1 = INP(17); const float* lq2 = INP(18); const float* lk2 = INP(19); const float* w_da = INP(21); const float* w_mix = INP(22); const float* g_mem = INP(25); const float* w_xq = INP(26); const float* w_xkv = INP(27); const float* w_xo = INP(28); const float* w_ff1 = INP(31); const float* w_ff2 = INP(32);
#ifdef DELAY_TEST
        { const unsigned long long t0 = __builtin_amdgcn_s_memrealtime(); while (__builtin_amdgcn_s_memrealtime() - t0 < (unsigned long long)DELAY_TEST) __builtin_amdgcn_s_sleep(10); }
#endif
#ifdef SCRIBBLE_TEST
        for (size_t i = (size_t)bx * 512 + tid; i < (size_t)M * D / 4; i += (size_t)G * 512) ((GAS f32x4*)out)[i] = (f32x4){1.0f, 2.0f, 3.0f, 4.0f};
#endif
        LAS float* scr = (LAS float*)(lds + wave * 16384);
        constexpr int I_IN = 16 * 192, I_SQ = 16 * 32, I_KV = 16 * 64, I_F1 = 16 * 128, I_F2 = 64 * 32;
        constexpr int NITEMS = I_IN + 6 * I_SQ + I_KV + I_F1 + I_F2;
        for (int it = gw; it < NITEMS; it += NGW) {
            int r = it;
            if (r < I_IN) { p0_transpose_item<FAST(0) != 0>(w_in, D, INC, Win, scr, r, lane); continue; } r -= I_IN;
            if (r < I_SQ) { p0_transpose_item<false>(w_glu, D, D, Wglu, scr, r, lane); continue; } r -= I_SQ;
            if (r < I_SQ) { p0_transpose_item<false>(w_ssm, D, D, Wssm, scr, r, lane); continue; } r -= I_SQ;
            if (r < I_SQ) { p0_transpose_item<false>(w_da, D, D, Wda, scr, r, lane); continue; } r -= I_SQ;
            if (r < I_SQ) { p0_transpose_item<false>(w_mix, D, D, Wmix, scr, r, lane); continue; } r -= I_SQ;
            if (r < I_SQ) { p0_transpose_item<false>(w_xq, D, D, Wxq, scr, r, lane); continue; } r -= I_SQ;
            if (r < I_SQ) { p0_transpose_item<false>(w_xo, D, D, Wxo, scr, r, lane); continue; } r -= I_SQ;
            if (r < I_KV) { p0_transpose_item<false>(w_xkv, D, 2 * D, Wxkv, scr, r, lane); continue; } r -= I_KV;
            if (r < I_F1) { p0_transpose_item<false>(w_ff1, D, FF, Wf1, scr, r, lane); continue; } r -= I_F1;
            p0_transpose_item<false>(w_ff2, FF, D, Wf2, scr, r, lane);
        }
        for (int m = gw; m < M; m += NGW) rms_row_to_bf16(x + (size_t)m * D, g_mix_pre, HB + (size_t)m * D, lane);
        for (int m = gw; m < MM; m += NGW) rms_row_to_bf16(mem + (size_t)m * D, g_mem, MEMN + (size_t)m * D, lane);
        for (int idx = vcu * 512 + tid; idx < SEQ * 32; idx += G * 512) { const int pos = idx >> 5, i = idx & 31; float c, s; sincos_reduced((double)pos * rope_inv(i), c, s); cosT[idx] = c; sinT[idx] = s; }
        for (int idx = vcu * 512 + tid; idx < SG * SP; idx += G * 512) {
            const int g = idx >> 6;
            const double lr = (double)lam_re[idx], li = (double)lam_im[idx], dt = exp((double)log_dt[g]);
            const double zr = lr * dt, zi = li * dt;
            float c1, s1; sincos_reduced(zi, c1, s1);
            const double er = exp(zr), br = er * (double)c1, bi = er * (double)s1;
            float c64, s64; sincos_reduced(64.0 * zi, c64, s64);
            const double e64 = exp(64.0 * zr);
            lamb[idx * 4 + 0] = (float)br; lamb[idx * 4 + 1] = (float)bi; lamb[idx * 4 + 2] = (float)(e64 * (double)c64); lamb[idx * 4 + 3] = (float)(e64 * (double)s64);
            const double nr = br - 1.0, ni = bi, den = lr * lr + li * li;
            const double fr = (nr * lr + ni * li) / den, fi = (ni * lr - nr * li) / den;
            for (int h = 0; h < SH; ++h) { const double b_r = (double)sb_re[idx * SH + h], b_i = (double)sb_im[idx * SH + h];
                bbar[idx * 32 + h] = (float)(fr * b_r - fi * b_i); bbar[idx * 32 + 16 + h] = (float)(fr * b_i + fi * b_r); }
        }
        if (vcu == 0 && wave == 0) {
            const float a = wave_sum(lq1[lane] * lk1[lane]), b = wave_sum(lq2[lane] * lk2[lane]);
            if (lane == 0) scal[0] = expf(a) - expf(b) + LAM_INIT;
        }
    }
    SEAM(0);
    if (IN(1)) { const float* b_gate = INP(4);
#ifdef SCRIBBLE_TEST
        { unsigned bad = 0;
          for (size_t i = (size_t)bx * 512 + tid; i < (size_t)M * D / 4; i += (size_t)G * 512) { const f32x4 v = ((const GAS f32x4*)out)[i]; bad |= (v[0] != 1.0f) | (v[1] != 2.0f) | (v[2] != 3.0f) | (v[3] != 4.0f); }
          if (bad) __hip_atomic_store(ctl + 8, 1u, RLX_AGENT);
          __syncthreads(); }
#endif

#if FAST(0)
        { pg8::Gemm g{HB, Win, M, INC, D}; pg8::StaticOrder S; S.init(M, INC, G, bx);
          pg8::EpiInProjF e{UB, QB, KB, VB, GT, cosT, sinT, b_gate, QSCALE};
          pg8::gemm_phase<pg8::EpiInProjF, pg8::StaticOrder, true, true>(lds, g, S, e); }
#if FAST(9)
        { pg8::Gemm g{MEMN, Wxkv, MM, 2 * D, D}; pg8::StaticOrder S; S.init(MM, 2 * D, G, bx);
          pg8::EpiBf16<0> e{KVM, 2 * D, 1.0f};
          pg8::gemm_phase<pg8::EpiBf16<0>, pg8::StaticOrder, true, true>(lds, g, S, e); }
#else
        { EpiStore e2{KVM, 2 * D, 1.0f}; ngemm(lds, MEMN, D, Wxkv, 1, D, MM, 2 * D, D, e2, vcu, G); }
#endif
#else
        EpiInProj e{UB, QB, KB, VB, GT, cosT, sinT, b_gate};
        ngemm(lds, HB, D, Win, 1, D, M, INC, D, e, vcu, G);
        EpiStore e2{KVM, 2 * D, 1.0f};
        ngemm(lds, MEMN, D, Wxkv, 1, D, MM, 2 * D, D, e2, vcu, G);
#endif

    }
    SEAM(1);
    if (IN(2)) {
        for (int unit = gw; unit < BATCH * SG * NCH; unit += NGW) {
            const int c = unit % NCH, g = (unit / NCH) % SG, b = unit / (NCH * SG);
            const int gp = g * SP + lane;
            const float lbr = lamb[gp * 4 + 0], lbi = lamb[gp * 4 + 1];
            float br[16], bi[16];
#pragma unroll
            for (int h = 0; h < 16; ++h) { br[h] = bbar[gp * 32 + h]; bi[h] = bbar[gp * 32 + 16 + h]; }
            float xr = 0.f, xi = 0.f;
            const bf16* up = UB + (size_t)(b * SEQ + c * CH) * D + g * SH;
            for (int t = 0; t < CH; ++t) {
                const v4u w0 = *(const GAS v4u*)(up + (size_t)t * D), w1 = *(const GAS v4u*)(up + (size_t)t * D + 8);
                const float u[16] = {bflo(w0.x), bfhi(w0.x), bflo(w0.y), bfhi(w0.y), bflo(w0.z), bfhi(w0.z), bflo(w0.w), bfhi(w0.w), bflo(w1.x), bfhi(w1.x), bflo(w1.y), bfhi(w1.y), bflo(w1.z), bfhi(w1.z), bflo(w1.w), bfhi(w1.w)};
                float ar = 0.f, ai = 0.f;
#pragma unroll
                for (int h = 0; h < 16; ++h) { ar += br[h] * u[h]; ai += bi[h] * u[h]; }
                const float nr = lbr * xr - lbi * xi + ar, ni = lbr * xi + lbi * xr + ai; xr = nr; xi = ni;
            }
            float* e = EB + ((size_t)((b * SG + g) * NCH + c) * SP + lane) * 2; e[0] = xr; e[1] = xi;
        }
    }
    SEAM(2);
    if (IN(3)) {
        for (int idx = vcu * 512 + tid; idx < BATCH * SG * SP; idx += G * 512) {
            const int p = idx & 63, g = (idx >> 6) & 63, b = idx >> 12; const int gp = g * SP + p;
            const float tr = lamb[gp * 4 + 2], ti = lamb[gp * 4 + 3];
            float sr = 0.f, si = 0.f;
            const size_t base = ((size_t)(b * SG + g) * NCH) * SP + p;
            for (int c = 0; c < NCH; ++c) {
                const size_t o = (base + (size_t)c * SP) * 2;
                SINB[o] = sr; SINB[o + 1] = si;
                const float er = EB[o], ei = EB[o + 1];
                const float nr = tr * sr - ti * si + er, ni = tr * si + ti * sr + ei; sr = nr; si = ni;
            }
        }
    }
    SEAM(3);
    if (IN(4)) { const float* sc_re = INP(10); const float* sc_im = INP(11); const float* ssm_d = INP(12);
        LAS float* xs = (LAS float*)(lds + wave * 1024);
        for (int unit = gw; unit < BATCH * SG * NCH; unit += NGW) {
            const int c = unit % NCH, g = (unit / NCH) % SG, b = unit / (NCH * SG);
            const int gp = g * SP + lane;
            const float lbr = lamb[gp * 4 + 0], lbi = lamb[gp * 4 + 1];
            float br[16], bi[16], cr[16], ci[16];
#pragma unroll
            for (int h = 0; h < 16; ++h) { br[h] = bbar[gp * 32 + h]; bi[h] = bbar[gp * 32 + 16 + h]; }
            const int hh = lane & 15, pq = lane >> 4;
#pragma unroll
            for (int j = 0; j < 16; ++j) { cr[j] = sc_re[(size_t)(g * SH + hh) * SP + pq * 16 + j]; ci[j] = sc_im[(size_t)(g * SH + hh) * SP + pq * 16 + j]; }
            const float dsk = ssm_d[g * SH + hh];
            const float* sp = SINB + ((size_t)((b * SG + g) * NCH + c) * SP + lane) * 2;
            float xr = sp[0], xi = sp[1];
            const bf16* up = UB + (size_t)(b * SEQ + c * CH) * D + g * SH;
            bf16* yp = HB + (size_t)(b * SEQ + c * CH) * D + g * SH;
            for (int t = 0; t < CH; ++t) {
                const v4u w0 = *(const GAS v4u*)(up + (size_t)t * D), w1 = *(const GAS v4u*)(up + (size_t)t * D + 8);
                const float u[16] = {bflo(w0.x), bfhi(w0.x), bflo(w0.y), bfhi(w0.y), bflo(w0.z), bfhi(w0.z), bflo(w0.w), bfhi(w0.w), bflo(w1.x), bfhi(w1.x), bflo(w1.y), bfhi(w1.y), bflo(w1.z), bfhi(w1.z), bflo(w1.w), bfhi(w1.w)};
                float ar = 0.f, ai = 0.f;
#pragma unroll
                for (int h = 0; h < 16; ++h) { ar += br[h] * u[h]; ai += bi[h] * u[h]; }
                const float nr = lbr * xr - lbi * xi + ar, ni = lbr * xi + lbi * xr + ai; xr = nr; xi = ni;
                xs[lane] = xr; xs[64 + lane] = xi;
                LDS_WAIT(); asm volatile("" ::: "memory");
                float y = 0.f;
#pragma unroll
                for (int j = 0; j < 16; ++j) y += cr[j] * xs[pq * 16 + j] - ci[j] * xs[64 + pq * 16 + j];
                y += __shfl_xor(y, 16); y += __shfl_xor(y, 32);
                float uh = u[0];
#pragma unroll
                for (int h = 1; h < 16; ++h) uh = (hh == h) ? u[h] : uh;
                y += dsk * uh;
                if (lane < 16) yp[(size_t)t * D + hh] = (bf16)f2bf(gelu_tanh(y));
                LDS_WAIT(); asm volatile("" ::: "memory");
            }
        }
    }
    SEAM(4);
    if (IN(5)) { const float* head_norm = INP(20);
        const float lam = scal[0];
        const int row = tid >> 3, sl = tid & 7;
        for (int i = 0; i < 8; ++i) {
            const int slot = (i & 1) ? (i * 256 + 255 - vcu) : (i * 256 + vcu);
            if (slot >= BATCH * 8 * 128) break;
            const int qc = 127 - (slot >> 4), bh = slot & 15, b = bh >> 3, h = bh & 7;
            const size_t rbase = (size_t)b * SEQ;
            const bf16* qp = QB + (rbase + qc * 64 + row) * D + h * 128;
            v4u q1p[8], q2p[8];
#pragma unroll
            for (int c8 = 0; c8 < 8; ++c8) { q1p[c8] = *(const GAS v4u*)(qp + c8 * 8); q2p[c8] = *(const GAS v4u*)(qp + 64 + c8 * 8); }
            float o1[16], o2[16]; float m1 = -1e30f, m2 = -1e30f, l1 = 0.f, l2 = 0.f;
#pragma unroll
            for (int j = 0; j < 16; ++j) { o1[j] = 0.f; o2[j] = 0.f; }
            const int nk = 64 * (qc + 1);
            for (int j = 0; j < nk; ++j) {
                const bf16* kp = KB + (rbase + j) * D + h * 128; const bf16* vp = VB + (rbase + j) * D + h * 128 + sl * 16;
                float s1 = 0.f, s2 = 0.f;
#pragma unroll
                for (int c8 = 0; c8 < 8; ++c8) { const v4u w = *(const GAS v4u*)(kp + c8 * 8); const v4u q = q1p[c8];
                    s1 += bflo(q.x) * bflo(w.x) + bfhi(q.x) * bfhi(w.x) + bflo(q.y) * bflo(w.y) + bfhi(q.y) * bfhi(w.y) + bflo(q.z) * bflo(w.z) + bfhi(q.z) * bfhi(w.z) + bflo(q.w) * bflo(w.w) + bfhi(q.w) * bfhi(w.w); }
#pragma unroll
                for (int c8 = 0; c8 < 8; ++c8) { const v4u w = *(const GAS v4u*)(kp + 64 + c8 * 8); const v4u q = q2p[c8];
                    s2 += bflo(q.x) * bflo(w.x) + bfhi(q.x) * bfhi(w.x) + bflo(q.y) * bflo(w.y) + bfhi(q.y) * bfhi(w.y) + bflo(q.z) * bflo(w.z) + bfhi(q.z) * bfhi(w.z) + bflo(q.w) * bflo(w.w) + bfhi(q.w) * bfhi(w.w); }
                const v4u v0 = *(const GAS v4u*)vp, v1 = *(const GAS v4u*)(vp + 8);
                const float vv[16] = {bflo(v0.x), bfhi(v0.x), bflo(v0.y), bfhi(v0.y), bflo(v0.z), bfhi(v0.z), bflo(v0.w), bfhi(v0.w), bflo(v1.x), bfhi(v1.x), bflo(v1.y), bfhi(v1.y), bflo(v1.z), bfhi(v1.z), bflo(v1.w), bfhi(v1.w)};
                { const float mn = fmaxf(m1, s1), a = __builtin_amdgcn_exp2f(m1 - mn), p = __builtin_amdgcn_exp2f(s1 - mn); m1 = mn; l1 = l1 * a + p;
#pragma unroll
                  for (int d = 0; d < 16; ++d) o1[d] = o1[d] * a + p * vv[d]; }
                { const float mn = fmaxf(m2, s2), a = __builtin_amdgcn_exp2f(m2 - mn), p = __builtin_amdgcn_exp2f(s2 - mn); m2 = mn; l2 = l2 * a + p;
#pragma unroll
                  for (int d = 0; d < 16; ++d) o2[d] = o2[d] * a + p * vv[d]; }
            }
            const float i1 = 1.0f / l1, i2 = lam / l2; float ss = 0.f;
#pragma unroll
            for (int d = 0; d < 16; ++d) { o1[d] = o1[d] * i1 - o2[d] * i2; ss += o1[d] * o1[d]; }
            ss += __shfl_xor(ss, 1); ss += __shfl_xor(ss, 2); ss += __shfl_xor(ss, 4);
            const float rs = (1.0f - LAM_INIT) / sqrtf(ss * (1.0f / 128.0f) + EPS);
            bf16* op = QB + (rbase + qc * 64 + row) * D + h * 128 + sl * 16;
            unsigned w[8];
#pragma unroll
            for (int d = 0; d < 8; ++d) w[d] = pk2(o1[2 * d] * rs * head_norm[sl * 16 + 2 * d], o1[2 * d + 1] * rs * head_norm[sl * 16 + 2 * d + 1]);
            *(GAS v4u*)op = (v4u){w[0], w[1], w[2], w[3]}; *(GAS v4u*)(op + 8) = (v4u){w[4], w[5], w[6], w[7]};
        }
    }
    SEAM(5);
    if (IN(6)) { const float* b_glu = INP(14);
#if FAST(1)
{ pg8::Gemm g{HB, Wglu, M, D, D}; pg8::StaticOrder S; S.init(M, D, G, bx); pg8::EpiGluF e{HB, UB, b_glu};
        pg8::gemm_phase<pg8::EpiGluF, pg8::StaticOrder, false, true>(lds, g, S, e); }
#else
{ EpiGlu e{HB, UB, b_glu}; ngemm(lds, HB, D, Wglu, 1, D, M, D, D, e, vcu, G); }
#endif
    }

    SEAM(6);
    if (IN(7)) {
#if FAST(2)
{ pg8::Gemm g{UB, Wssm, M, D, D}; pg8::StaticOrder S; S.init(M, D, G, bx); pg8::EpiMergeAF e{GT, (float*)KB};
        pg8::gemm_phase<pg8::EpiMergeAF, pg8::StaticOrder, false, true>(lds, g, S, e); }
#else
{ EpiMergeA e{GT, (float*)KB}; ngemm(lds, UB, D, Wssm, 1, D, M, D, D, e, vcu, G); }
#endif
    }

    SEAM(7);
    if (IN(8)) {
#if FAST(3)
{ pg8::Gemm g{QB, Wda, M, D, D}; pg8::StaticOrder S; S.init(M, D, G, bx); pg8::EpiMergeBF e{GT, (const float*)KB, UB};
        pg8::gemm_phase<pg8::EpiMergeBF, pg8::StaticOrder, false, true>(lds, g, S, e); }
#else
{ EpiMergeB e{GT, (const float*)KB, UB}; ngemm(lds, QB, D, Wda, 1, D, M, D, D, e, vcu, G); }
#endif
    }

    SEAM(8);
    if (IN(9)) {
#if FAST(4)
{ pg8::Gemm g{UB, Wmix, M, D, D}; pg8::StaticOrder S; S.init(M, D, G, bx); pg8::EpiBf16<0> e{QB, D, 1.0f};
        pg8::gemm_phase<pg8::EpiBf16<0>, pg8::StaticOrder, false, true>(lds, g, S, e); }
#else
{ EpiStore e{QB, D, 1.0f}; ngemm(lds, UB, D, Wmix, 1, D, M, D, D, e, vcu, G); }
#endif
    }

    SEAM(9);
    if (IN(10)) { const float* x = INP(0); const float* g_mix_post = INP(23); const float* g_x_pre = INP(24); for (int m = gw; m < M; m += NGW) resnorm_row(QB + (size_t)m * D, x + (size_t)m * D, g_mix_post, out + (size_t)m * D, g_x_pre, HB + (size_t)m * D, lane); }
    SEAM(10);
    if (IN(11)) {
#if FAST(5)
{ pg8::Gemm g{HB, Wxq, M, D, D}; pg8::StaticOrder S; S.init(M, D, G, bx); pg8::EpiBf16<0> e{UB, D, XSCALE};
        pg8::gemm_phase<pg8::EpiBf16<0>, pg8::StaticOrder, false, true>(lds, g, S, e); }
#else
{ EpiStore e{UB, D, XSCALE}; ngemm(lds, HB, D, Wxq, 1, D, M, D, D, e, vcu, G); }
#endif
    }

    SEAM(11);
    if (IN(12)) {
        LAS float* qs = (LAS float*)lds; LAS float* Ss = qs + 32 * 256;
        for (int unit = vcu; unit < BATCH * 4 * (SEQ / 32); unit += G) {
            const int rb = unit % (SEQ / 32), hd = (unit / (SEQ / 32)) & 3, b = unit / (4 * (SEQ / 32));
            const size_t r0 = (size_t)b * SEQ + rb * 32;
            for (int idx = tid; idx < 32 * 256; idx += 512) qs[idx] = bf2f(UB[(r0 + (idx >> 8)) * D + hd * 256 + (idx & 255)]);
            __syncthreads();
            const int row = tid >> 4, ks = tid & 15;
            for (int kk = 0; kk < 16; ++kk) {
                const int key = ks + 16 * kk; const bf16* kp = KVM + (size_t)(b * MEML + key) * 2048 + hd * 256;
                float s = 0.f;
                for (int d8 = 0; d8 < 32; ++d8) { const v4u w = *(const GAS v4u*)(kp + d8 * 8); const LAS float* q = qs + row * 256 + d8 * 8;
                    s += q[0] * bflo(w.x) + q[1] * bfhi(w.x) + q[2] * bflo(w.y) + q[3] * bfhi(w.y) + q[4] * bflo(w.z) + q[5] * bfhi(w.z) + q[6] * bflo(w.w) + q[7] * bfhi(w.w); }
                Ss[row * 256 + key] = s;
            }
            __syncthreads();
            { float mx = -1e30f;
              for (int kk = 0; kk < 16; ++kk) mx = fmaxf(mx, Ss[row * 256 + ks + 16 * kk]);
              mx = fmaxf(mx, __shfl_xor(mx, 1)); mx = fmaxf(mx, __shfl_xor(mx, 2)); mx = fmaxf(mx, __shfl_xor(mx, 4)); mx = fmaxf(mx, __shfl_xor(mx, 8));
              float sum = 0.f; float e[16];
#pragma unroll
              for (int kk = 0; kk < 16; ++kk) { e[kk] = __builtin_amdgcn_exp2f(Ss[row * 256 + ks + 16 * kk] - mx); sum += e[kk]; }
              sum += __shfl_xor(sum, 1); sum += __shfl_xor(sum, 2); sum += __shfl_xor(sum, 4); sum += __shfl_xor(sum, 8);
              const float inv = 1.0f / sum;
#pragma unroll
              for (int kk = 0; kk < 16; ++kk) Ss[row * 256 + ks + 16 * kk] = e[kk] * inv; }
            __syncthreads();
            { float o[16];
#pragma unroll
              for (int d = 0; d < 16; ++d) o[d] = 0.f;
              for (int mk = 0; mk < MEML; ++mk) { const float p = Ss[row * 256 + mk]; const bf16* vp = KVM + (size_t)(b * MEML + mk) * 2048 + 1024 + hd * 256 + ks * 16;
                  const v4u v0 = *(const GAS v4u*)vp, v1 = *(const GAS v4u*)(vp + 8);
                  o[0] += p * bflo(v0.x); o[1] += p * bfhi(v0.x); o[2] += p * bflo(v0.y); o[3] += p * bfhi(v0.y); o[4] += p * bflo(v0.z); o[5] += p * bfhi(v0.z); o[6] += p * bflo(v0.w); o[7] += p * bfhi(v0.w);
                  o[8] += p * bflo(v1.x); o[9] += p * bfhi(v1.x); o[10] += p * bflo(v1.y); o[11] += p * bfhi(v1.y); o[12] += p * bflo(v1.z); o[13] += p * bfhi(v1.z); o[14] += p * bflo(v1.w); o[15] += p * bfhi(v1.w); }
              bf16* op = QB + (r0 + row) * D + hd * 256 + ks * 16;
              *(GAS v4u*)op = (v4u){pk2(o[0], o[1]), pk2(o[2], o[3]), pk2(o[4], o[5]), pk2(o[6], o[7])};
              *(GAS v4u*)(op + 8) = (v4u){pk2(o[8], o[9]), pk2(o[10], o[11]), pk2(o[12], o[13]), pk2(o[14], o[15])}; }
            __syncthreads();
        }
    }
    SEAM(12);
    if (IN(13)) {
#if FAST(6)
{ pg8::Gemm g{QB, Wxo, M, D, D}; pg8::StaticOrder S; S.init(M, D, G, bx); pg8::EpiBf16<0> e{KB, D, 1.0f};
        pg8::gemm_phase<pg8::EpiBf16<0>, pg8::StaticOrder, false, true>(lds, g, S, e); }
#else
{ EpiStore e{KB, D, 1.0f}; ngemm(lds, QB, D, Wxo, 1, D, M, D, D, e, vcu, G); }
#endif
    }

    SEAM(13);
    if (IN(14)) { const float* g_x_post = INP(29); const float* g_ff_pre = INP(30); for (int m = gw; m < M; m += NGW) resnorm_row(KB + (size_t)m * D, out + (size_t)m * D, g_x_post, out + (size_t)m * D, g_ff_pre, HB + (size_t)m * D, lane); }
    SEAM(14);
    if (IN(15)) {
#if FAST(7)
{ pg8::Gemm g{HB, Wf1, M, FF, D}; pg8::StaticOrder S; S.init(M, FF, G, bx); pg8::EpiBf16<2> e{UB, FF, 1.0f};
        pg8::gemm_phase<pg8::EpiBf16<2>, pg8::StaticOrder, true, true>(lds, g, S, e); }
#else
{ EpiRelu2 e{UB, FF}; ngemm(lds, HB, D, Wf1, 1, D, M, FF, D, e, vcu, G); }
#endif
    }

    SEAM(15);
    if (IN(16)) {
#if FAST(8)
{ pg8::Gemm g{UB, Wf2, M, D, FF}; pg8::StaticOrder S; S.init(M, D, G, bx); pg8::EpiBf16<0> e{HB, D, 1.0f};
        pg8::gemm_phase<pg8::EpiBf16<0>, pg8::StaticOrder, false, true>(lds, g, S, e); }
#else
{ EpiStore e{HB, D, 1.0f}; ngemm(lds, UB, FF, Wf2, 1, FF, M, D, FF, e, vcu, G); }
#endif
    }

    SEAM(16);
    if (IN(17)) { const float* g_ff_post = INP(33); for (int m = gw; m < M; m += NGW) resnorm_row(HB + (size_t)m * D, out + (size_t)m * D, g_ff_post, out + (size_t)m * D, nullptr, nullptr, lane); }
#ifdef SCRIBBLE_TEST
    if (IN(17)) { VM_WAIT(); __syncthreads(); if (__hip_atomic_load(ctl + 8, RLX_AGENT) != 0u && bx == 0) { for (int i = tid; i < 4096; i += 512) out[i] = 1000.0f; } }
#endif
#undef IN
#undef SEAM
}

#ifdef RECOMP
__global__ void __launch_bounds__(NWAVES * 64, 2) recomp_kernel(Args args) {
    extern __shared__ __attribute__((aligned(16))) unsigned char lds_raw2[];
    LAS unsigned char* lds = (LAS unsigned char*)lds_raw2;
    const int G = gridDim.x; const int bx = blockIdx.x; const int vcu = (G % 8 == 0) ? (bx % 8) * (G / 8) + bx / 8 : bx;
    unsigned char* ws = args.ws;
    bf16* Win = (bf16*)(ws + WS_WIN); bf16* HB = (bf16*)(ws + WS_H); bf16* UB = (bf16*)(ws + WS_U); bf16* VB = (bf16*)(ws + WS_V); bf16* GT = (bf16*)args.out;
    if (RECOMP & 1) { EpiStore e{UB, D, 1.0f}; ngemm(lds, HB, D, Win, 1, D, M, D, D, e, vcu, G); }
    if (RECOMP & 6) { EpiVG e{VB, GT, args.in[4]}; ngemm(lds, HB, D, Win + (size_t)3072 * D, 1, D, M, 3072, D, e, vcu, G); }
}
#endif
constexpr int N_PHASES = 18;
extern "C" void kernel_launch(void* const* d_in, const int* in_sizes, int n_in, void* d_out, int out_size, void* d_ws, size_t ws_size, hipStream_t stream) {
    static int grid = 0;
    if (grid == 0) {
        if (n_in != 34 || in_sizes[0] != M * D || out_size != M * D || ws_size < WS_END) { fprintf(stderr, "kernel_launch: unexpected shapes (n_in %d, in0 %d, out %d, ws %zu)\n", n_in, n_in > 0 ? in_sizes[0] : -1, out_size, ws_size); grid = -1; return; }
        int dev = 0, cus = 0, per_cu = 0;
        if (hipGetDevice(&dev) != hipSuccess || hipDeviceGetAttribute(&cus, hipDeviceAttributeMultiprocessorCount, dev) != hipSuccess) { grid = -1; return; }
        if (hipFuncSetAttribute((const void*)mk_fwd, hipFuncAttributeMaxDynamicSharedMemorySize, LDS_BYTES) != hipSuccess) { fprintf(stderr, "kernel_launch: hipFuncSetAttribute failed\n"); grid = -1; return; }
        if (hipOccupancyMaxActiveBlocksPerMultiprocessor(&per_cu, (const void*)mk_fwd, NWAVES * 64, LDS_BYTES) != hipSuccess || per_cu < 1) { fprintf(stderr, "kernel_launch: occupancy query says %d\n", per_cu); per_cu = 1; }
        (void)hipGetLastError();
        grid = cus;
    }
    if (grid < 0) return;
    if (hipMemsetAsync((char*)d_ws + WS_CTL, 0, CTL_ZERO_BYTES, stream) != hipSuccess) return;
    Args a{};
    for (int i = 0; i < 34; ++i) a.in[i] = (const float*)d_in[i];
    a.out = (float*)d_out; a.ws = (unsigned char*)d_ws;
    if (MK_N_LAUNCHES == 1) { a.ph_lo = 0; a.ph_hi = N_PHASES; a.li = 0; hipLaunchKernelGGL(mk_fwd, dim3(grid), dim3(NWAVES * 64), LDS_BYTES, stream, a); }
    else { for (int p = 0; p < N_PHASES; ++p) { a.ph_lo = p; a.ph_hi = p + 1; a.li = p; hipLaunchKernelGGL(mk_fwd, dim3(grid), dim3(NWAVES * 64), LDS_BYTES, stream, a);
#ifdef RECOMP
        if (p == 1) { (void)hipFuncSetAttribute((const void*)recomp_kernel, hipFuncAttributeMaxDynamicSharedMemorySize, LDS_BYTES); hipLaunchKernelGGL(recomp_kernel, dim3(grid), dim3(NWAVES * 64), LDS_BYTES, stream, a); }
#endif
    } }
}
```

```cpp
#include <hip/hip_runtime.h>
#include <cstdio>
#include <cstdint>

#ifndef MK_N_LAUNCHES
#define MK_N_LAUNCHES 1
#endif

#ifndef FAST_MASK
#define FAST_MASK 0x7FF
#endif
#define FAST(k) ((FAST_MASK >> (k)) & 1)
#define GAS __attribute__((address_space(1)))
#define LAS __attribute__((address_space(3)))
typedef unsigned short bf16;
typedef unsigned v4u __attribute__((ext_vector_type(4)));
typedef unsigned v2u __attribute__((ext_vector_type(2)));
typedef float f32x4 __attribute__((ext_vector_type(4)));
typedef GAS unsigned gu32;
#define RLX_AGENT __ATOMIC_RELAXED, __HIP_MEMORY_SCOPE_AGENT
#define LDS_WAIT() asm volatile("s_waitcnt lgkmcnt(0)" ::: "memory")
#define VM_WAIT() asm volatile("s_waitcnt vmcnt(0)" ::: "memory")

constexpr int BATCH = 2, SEQ = 8192, D = 1024, M = BATCH * SEQ, INC = 6144, FF = 4096, MEML = 256, MM = BATCH * MEML;
constexpr int SG = 64, SH = 16, SP = 64;
constexpr int CH = 64, NCH = SEQ / CH;
constexpr float EPS = 1e-6f;
constexpr float LOG2E = 1.4426950408889634f;
constexpr float QSCALE = 0.125f * LOG2E;
constexpr float XSCALE = 0.0625f * LOG2E;
constexpr float LAM_INIT = 0.2f;

constexpr size_t MiB = 1u << 20;
constexpr size_t WS_CTL = 0, CTL_ZERO_BYTES = 64 * 1024;
constexpr size_t WS_SCAL = 64 * 1024;
constexpr size_t WS_SSMP = 128 * 1024;
constexpr size_t WS_COS = 1 * MiB, WS_SIN = 2 * MiB;
constexpr size_t WS_MEMN = 3 * MiB;
constexpr size_t WS_KVM = 4 * MiB;
constexpr size_t WS_WIN = 8 * MiB;
constexpr size_t WS_WGLU = 20 * MiB, WS_WSSM = 22 * MiB, WS_WDA = 24 * MiB, WS_WMIX = 26 * MiB, WS_WXQ = 28 * MiB, WS_WXO = 30 * MiB;
constexpr size_t WS_WXKV = 32 * MiB;
constexpr size_t WS_WF1 = 36 * MiB;
constexpr size_t WS_WF2 = 44 * MiB;
constexpr size_t WS_H = 52 * MiB, WS_U = 84 * MiB, WS_Q = 116 * MiB, WS_K = 148 * MiB, WS_V = 180 * MiB;
constexpr size_t WS_E = 212 * MiB, WS_SIN_C = 220 * MiB;
constexpr size_t WS_END = 228 * MiB;
constexpr int CW_BAR = 1024;

constexpr int RING_BYTES = 131072, LDS_BYTES = 147456, LDSCTL_OFF = LDS_BYTES - 1024, MISC_OFF = LDSCTL_OFF + 320;
constexpr int NWAVES = 8;

__device__ __forceinline__ unsigned f2bf(float f) { unsigned u = __builtin_bit_cast(unsigned, f); return (u + 0x7fffu + ((u >> 16) & 1u)) >> 16; }
__device__ __forceinline__ unsigned pk2(float lo, float hi) { return f2bf(lo) | (f2bf(hi) << 16); }
__device__ __forceinline__ float bf2f(unsigned short h) { return __builtin_bit_cast(float, (unsigned)h << 16); }
__device__ __forceinline__ float bflo(unsigned w) { return __builtin_bit_cast(float, w << 16); }
__device__ __forceinline__ float bfhi(unsigned w) { return __builtin_bit_cast(float, w & 0xffff0000u); }

#define XB_TMO      128
#define XB_XCNT(j)  (256  + 64 * (j))
#define XB_XSUB(j)  (1280 + 64 * (j))
#define XB_XGEN(j)  (2304 + 64 * (j))
#define XB_TOP      3328
#define XB_TOPGEN   3392
#define XCD_BAR_WORDS 3456
#define XB_SPIN_CAP (1u << 18)
__device__ __forceinline__ unsigned xb_ld(unsigned* p)              { return __hip_atomic_load(p, __ATOMIC_RELAXED, __HIP_MEMORY_SCOPE_AGENT); }
__device__ __forceinline__ unsigned xb_add(unsigned* p, unsigned v) { return __hip_atomic_fetch_add(p, v, __ATOMIC_RELAXED, __HIP_MEMORY_SCOPE_AGENT); }
__device__ __forceinline__ unsigned xb_xcc_id() { return (unsigned)__builtin_amdgcn_s_getreg((3 << 11) | 20) & 0xFu; }
#define XB_SPIN(cond, bar) do { unsigned _sp = 0; while (cond) { __builtin_amdgcn_s_sleep(1); \
    if ((++_sp & 255u) == 0u) { if (xb_ld(&(bar)[XB_TMO])) break; if (_sp > XB_SPIN_CAP) { atomicAdd(&(bar)[XB_TMO], 1u); break; } } } } while (0)
struct XcdBarrier { unsigned* bar; unsigned x; volatile LAS unsigned* st; };
__device__ __forceinline__ XcdBarrier xcd_barrier_post(unsigned* bar, volatile LAS unsigned* st) {
    XcdBarrier b; b.bar = bar; b.x = xb_xcc_id(); b.st = st;
    if (threadIdx.x == 0) (void)xb_add(&bar[XB_XCNT(b.x)], 1u);
    return b;
}
__device__ __forceinline__ void xcd_barrier_complete(unsigned* bar, unsigned x, unsigned& nloc, unsigned& nx) {
    const unsigned G = gridDim.x * gridDim.y * gridDim.z;
    unsigned sum, cnt, mine, sp = 0u;
    for (;;) {
        sum = 0u; cnt = 0u; mine = 0u;
#pragma unroll
        for (unsigned j = 0; j < 16; ++j) { const unsigned c = xb_ld(&bar[XB_XCNT(j)]); sum += c; cnt += (c > 0u) ? 1u : 0u; mine = (j == x) ? c : mine; }
        if (sum == G) break;
        __builtin_amdgcn_s_sleep(1);
        if ((++sp & 255u) == 0u) { if (xb_ld(&bar[XB_TMO])) break; if (sp > XB_SPIN_CAP) { atomicAdd(&bar[XB_TMO], 1u); break; } }
    }
    nloc = mine > 0u ? mine : 1u; nx = cnt > 0u ? cnt : 1u;
}
__device__ __forceinline__ void xcd_barrier(const XcdBarrier& b) {
    asm volatile("s_waitcnt vmcnt(0)" ::: "memory");
    __syncthreads();
    if (threadIdx.x == 0) {
        unsigned* bar = b.bar;
        __builtin_amdgcn_s_waitcnt(0);
        unsigned nloc = b.st[0], nx = b.st[1];
        if (nloc == 0u) { xcd_barrier_complete(bar, b.x, nloc, nx); b.st[0] = nloc; b.st[1] = nx; }
        const unsigned old = xb_add(&bar[XB_XSUB(b.x)], 1u);
        const unsigned gen = old / nloc;
        if (old + 1u == (gen + 1u) * nloc) {
            __builtin_amdgcn_fence(__ATOMIC_RELEASE, "agent");
            asm volatile("s_waitcnt vmcnt(0)" ::: "memory");
            const unsigned og = xb_add(&bar[XB_TOP], 1u);
            const unsigned tg = og / nx;
            if (og + 1u == (tg + 1u) * nx) xb_add(&bar[XB_TOPGEN], 1u);
            else XB_SPIN(xb_ld(&bar[XB_TOPGEN]) == tg, bar);
            __builtin_amdgcn_fence(__ATOMIC_ACQUIRE, "agent");
            xb_add(&bar[XB_XGEN(b.x)], 1u);
            asm volatile("s_waitcnt vmcnt(0)" ::: "memory");
        } else {
            XB_SPIN(xb_ld(&bar[XB_XGEN(b.x)]) == gen, bar);
            __builtin_amdgcn_fence(__ATOMIC_ACQUIRE, "agent");
            asm volatile("s_waitcnt vmcnt(0)" ::: "memory");
        }
    }
    __syncthreads();
}

struct Frame {
    LAS unsigned char* lds;
    int tid, lane, wave, vcu, G;
    const float* const* in;
};
struct Args { const float* in[34]; float* out; unsigned char* ws; int ph_lo, ph_hi, li, pad; };

__device__ __forceinline__ float wave_sum(float v) {
#pragma unroll
    for (int o = 1; o < 64; o <<= 1) v += __shfl_xor(v, o);
    return v;
}

__device__ __forceinline__ int rope_dest(int col) { const int s = col & 127, a = s >> 6, n = (s >> 5) & 1, b = (s >> 4) & 1, rest = s & 15; return (col & ~127) + 64 * a + 32 * b + 8 * (rest >> 2) + 4 * n + (rest & 3); }
template <bool ROPEPERM>
__device__ __forceinline__ void p0_transpose_item(const float* W, int K, int N, bf16* WT, LAS float* scr, int item, int lane) {
    const int nblk = N / 32, kb = item / nblk, nb = item % nblk, k0 = 64 * kb, n0 = 32 * nb;
#pragma unroll 8
    for (int i = 0; i < 32; ++i) { const int kk = 2 * i + (lane >> 5); scr[kk * 33 + (lane & 31)] = W[(size_t)(k0 + kk) * N + n0 + (lane & 31)]; }
    LDS_WAIT(); asm volatile("" ::: "memory");
    const int c = lane & 7;
#pragma unroll
    for (int j = 0; j < 4; ++j) { const int n = (lane >> 3) + 8 * j; const LAS float* s = scr + (8 * c) * 33 + n;
        v4u o; o.x = pk2(s[0 * 33], s[1 * 33]); o.y = pk2(s[2 * 33], s[3 * 33]); o.z = pk2(s[4 * 33], s[5 * 33]); o.w = pk2(s[6 * 33], s[7 * 33]);
        const int drow = (ROPEPERM && (n0 + n) >= 1024 && (n0 + n) < 3072) ? rope_dest(n0 + n) : (n0 + n);
        *(GAS v4u*)(WT + (size_t)drow * K + k0 + 8 * c) = o; }
    LDS_WAIT(); asm volatile("" ::: "memory");
}
__device__ __forceinline__ void rms_row_to_bf16(const float* xrow, const float* g, bf16* orow, int lane) {
    const GAS f32x4* xr = (const GAS f32x4*)xrow + lane; const GAS f32x4* gr = (const GAS f32x4*)g + lane;
    f32x4 v[4]; float s = 0.f;
#pragma unroll
    for (int j = 0; j < 4; ++j) { v[j] = xr[64 * j]; s += (v[j].x * v[j].x + v[j].y * v[j].y) + (v[j].z * v[j].z + v[j].w * v[j].w); }
    const float rs = 1.0f / sqrtf(wave_sum(s) * (1.f / D) + EPS);
    GAS v2u* o8 = (GAS v2u*)orow + lane;
#pragma unroll
    for (int j = 0; j < 4; ++j) { const f32x4 gg = gr[64 * j]; v2u w; w.x = pk2(v[j].x * rs * gg.x, v[j].y * rs * gg.y); w.y = pk2(v[j].z * rs * gg.z, v[j].w * rs * gg.w); o8[64 * j] = w; }
}
__device__ __forceinline__ void resnorm_row(const bf16* yrow, const float* xi, const float* g1, float* xo, const float* g2, bf16* hn, int lane) {
    const GAS v2u* yr = (const GAS v2u*)yrow + lane; const GAS f32x4* xr = (const GAS f32x4*)xi + lane; const GAS f32x4* g1r = (const GAS f32x4*)g1 + lane;
    f32x4 y[4], x[4]; float s = 0.f;
#pragma unroll
    for (int j = 0; j < 4; ++j) { const v2u w = yr[64 * j]; y[j] = (f32x4){bflo(w.x), bfhi(w.x), bflo(w.y), bfhi(w.y)}; x[j] = xr[64 * j];
        s += (y[j].x * y[j].x + y[j].y * y[j].y) + (y[j].z * y[j].z + y[j].w * y[j].w); }
    const float rs = 1.0f / sqrtf(wave_sum(s) * (1.f / D) + EPS);
    float s2 = 0.f;
#pragma unroll
    for (int j = 0; j < 4; ++j) { const f32x4 gg = g1r[64 * j]; x[j] = x[j] + y[j] * rs * gg; s2 += (x[j].x * x[j].x + x[j].y * x[j].y) + (x[j].z * x[j].z + x[j].w * x[j].w); }
    GAS f32x4* xw = (GAS f32x4*)xo + lane;
#pragma unroll
    for (int j = 0; j < 4; ++j) xw[64 * j] = x[j];
    if (hn) {
        const float rs2 = 1.0f / sqrtf(wave_sum(s2) * (1.f / D) + EPS);
        const GAS f32x4* g2r = (const GAS f32x4*)g2 + lane; GAS v2u* o8 = (GAS v2u*)hn + lane;
#pragma unroll
        for (int j = 0; j < 4; ++j) { const f32x4 gg = g2r[64 * j]; v2u w; w.x = pk2(x[j].x * rs2 * gg.x, x[j].y * rs2 * gg.y); w.y = pk2(x[j].z * rs2 * gg.z, x[j].w * rs2 * gg.w); o8[64 * j] = w; }
    }
}

__device__ __forceinline__ double rope_inv(int i) {
    const double r = 0.74989420933245582730218427561514;
    double v = 1.0;
    for (int k = 0; k < i; ++k) v *= r;
    return v;
}
__device__ __forceinline__ void sincos_reduced(double ang, float& c, float& s) {
    const double inv2pi = 0.15915494309189533576888376337251;
    const double twopi = 6.283185307179586476925286766559;
    const double k = __builtin_rint(ang * inv2pi);
    const float r = (float)(ang - k * twopi);
    c = cosf(r); s = sinf(r);
}

namespace pg8 {
#define PG8_LAS __attribute__((address_space(3)))
typedef unsigned short bf16_t;
typedef short bf16x8 __attribute__((ext_vector_type(8)));
typedef float f32x4 __attribute__((ext_vector_type(4)));
typedef unsigned u32x4 __attribute__((ext_vector_type(4)));
constexpr int BM = 256, BK = 64, HALF = 128, HTB = HALF * BK * 2  , STAGE_BYTES = 8 * HTB, NXCD = 8, WGM = 8;

__host__ __device__ __forceinline__ int lds_byte(int r, int c) { const int st = (r >> 4) * 2 + (c >> 5), rr = r & 15, cc = c & 31, ob = rr * 64 + cc * 2; return st * 1024 + (ob ^ (((ob >> 9) & 1) << 5)); }
__host__ __device__ __forceinline__ void stage_rc(int b, int& R, int& C) { const int st = b / 1024, sb = b % 1024, swz = sb ^ (((sb >> 9) & 1) << 5); R = (st >> 1) * 16 + swz / 64; C = (st & 1) * 32 + (swz % 64) / 2; }
__host__ __device__ __forceinline__ int perm32(int rho) { const int n = rho >> 4, i = rho & 15; return 8 * (i >> 2) + 4 * n + (i & 3); }

struct Unit { int pm, pn; };
struct Gemm { const bf16_t* A; const bf16_t* Bt; int M, N, K; };

struct StaticOrder {
    int nM, nN, nwg, G, c;
    __host__ __device__ void init(int M, int N, int G_, int c_) { nM = M / BM; nN = N / BM; nwg = nM * nN; G = G_; c = c_; }
    __host__ __device__ bool next(int i, Unit& u) const {
        const long L = (long)i * G + c; if (L >= nwg) return false;
        int wgid = (int)L; { const int q = nwg / NXCD, r = nwg % NXCD, xcd = wgid % NXCD, off = wgid / NXCD; wgid = (xcd < r ? xcd * (q + 1) : r * (q + 1) + (xcd - r) * q) + off; }
        const int nig = WGM * nN, gid = wgid / nig, fm = gid * WGM, gsz = (nM - fm) < WGM ? (nM - fm) : WGM;
        u.pm = fm + ((wgid % nig) % gsz); u.pn = (wgid % nig) / gsz; return true;
    }
    __device__ __forceinline__ void a_ready(const Unit&) const {}
    __device__ __forceinline__ void done(const Unit&) const {}
};


typedef float cvt_f32x2 __attribute__((ext_vector_type(2))); typedef __bf16 cvt_bf16x2 __attribute__((ext_vector_type(2)));
__device__ __forceinline__ unsigned cvt_pk_bf16(float lo, float hi) { cvt_f32x2 v = {lo, hi}; cvt_bf16x2 b = __builtin_convertvector(v, cvt_bf16x2); return __builtin_bit_cast(unsigned, b); }
typedef unsigned u32x2 __attribute__((ext_vector_type(2)));
__device__ __forceinline__ float fsigmoid(float v) { return __builtin_amdgcn_rcpf(1.0f + __builtin_amdgcn_exp2f(-1.4426950408889634f * v)); }
__device__ __forceinline__ f32x4 sig4(f32x4 v) { return (f32x4){fsigmoid(v[0]), fsigmoid(v[1]), fsigmoid(v[2]), fsigmoid(v[3])}; }
__device__ __forceinline__ f32x4 bf4(unsigned lo, unsigned hi) { return (f32x4){__builtin_bit_cast(float, lo << 16), __builtin_bit_cast(float, lo & 0xffff0000u), __builtin_bit_cast(float, hi << 16), __builtin_bit_cast(float, hi & 0xffff0000u)}; }

template <int ACT  > struct EpiBf16 {
    static constexpr bool PERM = true, AFTER_DRAIN = false;
    bf16_t* O; int ldc; float scale;
    __device__ __forceinline__ void operator()(const f32x4 (&acc)[2][2][4][2], const Unit& u, int wr, int wc, int fr, int fq) const {
        const int row0 = u.pm * BM + wr * 64 + fr, col0 = u.pn * BM + wc * 32 + 8 * fq;
#pragma unroll
        for (int ai = 0; ai < 2; ++ai)
#pragma unroll
            for (int m = 0; m < 4; ++m) { bf16_t* rowp = O + (size_t)(row0 + ai * HALF + m * 16) * ldc + col0;
#pragma unroll
                for (int bj = 0; bj < 2; ++bj) { f32x4 v0 = acc[ai][bj][m][0], v1 = acc[ai][bj][m][1];
                    if (ACT == 2) { v0 = __builtin_elementwise_max(v0, (f32x4){0.f, 0.f, 0.f, 0.f}); v1 = __builtin_elementwise_max(v1, (f32x4){0.f, 0.f, 0.f, 0.f}); v0 = v0 * v0; v1 = v1 * v1; }
                    else { v0 = v0 * scale; v1 = v1 * scale; }
                    u32x4 w; w.x = cvt_pk_bf16(v0[0], v0[1]); w.y = cvt_pk_bf16(v0[2], v0[3]); w.z = cvt_pk_bf16(v1[0], v1[1]); w.w = cvt_pk_bf16(v1[2], v1[3]);
                    *(u32x4*)(rowp + bj * HALF) = w; } }
    }
};
struct EpiInProjF {
    static constexpr bool PERM = true, AFTER_DRAIN = false;
    bf16_t *U, *Q, *K, *V, *Gt; const float *cosT, *sinT, *bgate; float qscale;
    __device__ __forceinline__ void operator()(const f32x4 (&acc)[2][2][4][2], const Unit& u, int wr, int wc, int fr, int fq) const {
        const int row0 = u.pm * BM + wr * 64 + fr, pn = u.pn;
        if (pn >= 4 && pn < 12) {
            bf16_t* dst = (pn < 8) ? Q : K; const float sc = (pn < 8) ? qscale : 1.0f;
            const int i0 = 16 * (wc & 1) + 4 * fq, cbase = (pn & 3) * 256 + 64 * (wc >> 1) + i0;
#pragma unroll
            for (int ai = 0; ai < 2; ++ai)
#pragma unroll
                for (int m = 0; m < 4; ++m) { const int row = row0 + ai * HALF + m * 16, pos = row & 8191;
                    const f32x4 cs = *(const f32x4*)(cosT + pos * 32 + i0) * sc, sn = *(const f32x4*)(sinT + pos * 32 + i0) * sc;
                    bf16_t* rowp = dst + (size_t)row * 1024 + cbase;
#pragma unroll
                    for (int bj = 0; bj < 2; ++bj) { const f32x4 t1 = acc[ai][bj][m][0], t2 = acc[ai][bj][m][1];
                        const f32x4 o1 = t1 * cs - t2 * sn, o2 = t2 * cs + t1 * sn;
                        u32x2 w1, w2; w1.x = cvt_pk_bf16(o1[0], o1[1]); w1.y = cvt_pk_bf16(o1[2], o1[3]); w2.x = cvt_pk_bf16(o2[0], o2[1]); w2.y = cvt_pk_bf16(o2[2], o2[3]);
                        *(u32x2*)(rowp + bj * HALF) = w1; *(u32x2*)(rowp + bj * HALF + 32) = w2; } }
        } else if (pn >= 16) {
            const int col0 = (pn - 16) * 256 + wc * 32 + 8 * fq;
            f32x4 bv[2][2];
#pragma unroll
            for (int bj = 0; bj < 2; ++bj)
#pragma unroll
                for (int n = 0; n < 2; ++n) bv[bj][n] = *(const f32x4*)(bgate + col0 + bj * HALF + 4 * n);
#pragma unroll
            for (int ai = 0; ai < 2; ++ai)
#pragma unroll
                for (int m = 0; m < 4; ++m) { bf16_t* rowp = Gt + (size_t)(row0 + ai * HALF + m * 16) * 2048 + col0;
#pragma unroll
                    for (int bj = 0; bj < 2; ++bj) { const f32x4 v0 = sig4(acc[ai][bj][m][0] + bv[bj][0]), v1 = sig4(acc[ai][bj][m][1] + bv[bj][1]);
                        u32x4 w; w.x = cvt_pk_bf16(v0[0], v0[1]); w.y = cvt_pk_bf16(v0[2], v0[3]); w.z = cvt_pk_bf16(v1[0], v1[1]); w.w = cvt_pk_bf16(v1[2], v1[3]);
                        *(u32x4*)(rowp + bj * HALF) = w; } }
        } else {
            bf16_t* dst = (pn < 4) ? U : V; const int col0 = (pn & 3) * 256 + wc * 32 + 8 * fq;
#pragma unroll
            for (int ai = 0; ai < 2; ++ai)
#pragma unroll
                for (int m = 0; m < 4; ++m) { bf16_t* rowp = dst + (size_t)(row0 + ai * HALF + m * 16) * 1024 + col0;
#pragma unroll
                    for (int bj = 0; bj < 2; ++bj) { const f32x4 v0 = acc[ai][bj][m][0], v1 = acc[ai][bj][m][1];
                        u32x4 w; w.x = cvt_pk_bf16(v0[0], v0[1]); w.y = cvt_pk_bf16(v0[2], v0[3]); w.z = cvt_pk_bf16(v1[0], v1[1]); w.w = cvt_pk_bf16(v1[2], v1[3]);
                        *(u32x4*)(rowp + bj * HALF) = w; } }
        }
    }
};
struct EpiGluF {
    static constexpr bool PERM = true, AFTER_DRAIN = false;
    const bf16_t* YS; bf16_t* O; const float* bglu;
    __device__ __forceinline__ void operator()(const f32x4 (&acc)[2][2][4][2], const Unit& u, int wr, int wc, int fr, int fq) const {
        const int row0 = u.pm * BM + wr * 64 + fr, col0 = u.pn * BM + wc * 32 + 8 * fq;
        f32x4 bv[2][2];
#pragma unroll
        for (int bj = 0; bj < 2; ++bj)
#pragma unroll
            for (int n = 0; n < 2; ++n) bv[bj][n] = *(const f32x4*)(bglu + col0 + bj * HALF + 4 * n);
#pragma unroll
        for (int ai = 0; ai < 2; ++ai)
#pragma unroll
            for (int m = 0; m < 4; ++m) { const size_t off = (size_t)(row0 + ai * HALF + m * 16) * 1024 + col0;
#pragma unroll
                for (int bj = 0; bj < 2; ++bj) { const u32x4 yw = *(const u32x4*)(YS + off + bj * HALF);
                    const f32x4 v0 = bf4(yw.x, yw.y) * sig4(acc[ai][bj][m][0] + bv[bj][0]), v1 = bf4(yw.z, yw.w) * sig4(acc[ai][bj][m][1] + bv[bj][1]);
                    u32x4 w; w.x = cvt_pk_bf16(v0[0], v0[1]); w.y = cvt_pk_bf16(v0[2], v0[3]); w.z = cvt_pk_bf16(v1[0], v1[1]); w.w = cvt_pk_bf16(v1[2], v1[3]);
                    *(u32x4*)(O + off + bj * HALF) = w; } }
    }
};
struct EpiMergeAF {
    static constexpr bool PERM = true, AFTER_DRAIN = false;
    const bf16_t* Gt; float* TMP;
    __device__ __forceinline__ void operator()(const f32x4 (&acc)[2][2][4][2], const Unit& u, int wr, int wc, int fr, int fq) const {
        const int row0 = u.pm * BM + wr * 64 + fr, col0 = u.pn * BM + wc * 32 + 8 * fq;
#pragma unroll
        for (int ai = 0; ai < 2; ++ai)
#pragma unroll
            for (int m = 0; m < 4; ++m) { const size_t row = (size_t)(row0 + ai * HALF + m * 16);
#pragma unroll
                for (int bj = 0; bj < 2; ++bj) { const u32x4 gw = *(const u32x4*)(Gt + row * 2048 + col0 + bj * HALF);
                    float* tp = TMP + row * 1024 + col0 + bj * HALF;
                    *(f32x4*)tp = bf4(gw.x, gw.y) * acc[ai][bj][m][0]; *(f32x4*)(tp + 4) = bf4(gw.z, gw.w) * acc[ai][bj][m][1]; } }
    }
};
struct EpiMergeBF {
    static constexpr bool PERM = true, AFTER_DRAIN = false;
    const bf16_t* Gt; const float* TMP; bf16_t* O;
    __device__ __forceinline__ void operator()(const f32x4 (&acc)[2][2][4][2], const Unit& u, int wr, int wc, int fr, int fq) const {
        const int row0 = u.pm * BM + wr * 64 + fr, col0 = u.pn * BM + wc * 32 + 8 * fq;
#pragma unroll
        for (int ai = 0; ai < 2; ++ai)
#pragma unroll
            for (int m = 0; m < 4; ++m) { const size_t row = (size_t)(row0 + ai * HALF + m * 16);
#pragma unroll
                for (int bj = 0; bj < 2; ++bj) { const u32x4 gw = *(const u32x4*)(Gt + row * 2048 + 1024 + col0 + bj * HALF);
                    const float* tp = TMP + row * 1024 + col0 + bj * HALF;
                    const f32x4 v0 = *(const f32x4*)tp + bf4(gw.x, gw.y) * acc[ai][bj][m][0], v1 = *(const f32x4*)(tp + 4) + bf4(gw.z, gw.w) * acc[ai][bj][m][1];
                    u32x4 w; w.x = cvt_pk_bf16(v0[0], v0[1]); w.y = cvt_pk_bf16(v0[2], v0[3]); w.z = cvt_pk_bf16(v1[0], v1[1]); w.w = cvt_pk_bf16(v1[2], v1[3]);
                    *(u32x4*)(O + row * 1024 + col0 + bj * HALF) = w; } }
    }
};
template <class Epi, class Sched, bool ALIGN_EPI = false, bool SP2 = false>
__device__ __forceinline__ void gemm_phase(PG8_LAS unsigned char* lds, const Gemm g, const Sched& S, const Epi& E) {
    const int tid = threadIdx.x, wid = __builtin_amdgcn_readfirstlane(tid >> 6), lane = tid & 63, wr = wid >> 2, wc = wid & 3, fr = lane & 15, fq = lane >> 4;
    const int K = g.K, nt = K / BK;
    unsigned voffA[2], voffB[2];
#pragma unroll
    for (int i = 0; i < 2; ++i) { int R, C; stage_rc(tid * 16 + i * 8192, R, C); const int Rb = Epi::PERM ? ((R & ~31) + perm32(R & 31)) : R;
        voffA[i] = (unsigned)(R * K + C) * 2u; voffB[i] = (unsigned)(Rb * K + C) * 2u; }
    const size_t kstep = (size_t)(BK * 2);
    const size_t hstep = (size_t)HALF * K * 2;
    const size_t tstep = 2 * hstep;
    const unsigned ldsw = (unsigned)wid * 1024u;
    const int aoff = lds_byte(wr * 64 + fr, fq * 8), boff = lds_byte(wc * 32 + fr, fq * 8);
#define PG8_SA(b, h) (((b) * 2 + (h)) * HTB)
#define PG8_SB(b, h) ((4 + (b) * 2 + (h)) * HTB)
#define PG8_STAGE(bufoff, gbase, voff) do { _Pragma("unroll") for (int _i = 0; _i < 2; ++_i) \
        __builtin_amdgcn_global_load_lds((const unsigned*)((const char*)(gbase) + (voff)[_i]), (PG8_LAS unsigned*)(lds + (bufoff) + ldsw + _i * 8192), 16, 0, 0); } while (0)
#define PG8_LDA(dst, b, h) do { _Pragma("unroll") for (int m = 0; m < 4; ++m) _Pragma("unroll") for (int k = 0; k < 2; ++k) dst[m][k] = *(const PG8_LAS bf16x8*)(lds + PG8_SA(b, h) + aoff + m * 2048 + k * 1024); } while (0)
#define PG8_LDB(dst, b, h) do { _Pragma("unroll") for (int n = 0; n < 2; ++n) _Pragma("unroll") for (int k = 0; k < 2; ++k) dst[n][k] = *(const PG8_LAS bf16x8*)(lds + PG8_SB(b, h) + boff + n * 2048 + k * 1024); } while (0)
#define PG8_MMA(ai, bj, At, Bt) do { __builtin_amdgcn_s_setprio(1); _Pragma("unroll") for (int m = 0; m < 4; ++m) _Pragma("unroll") for (int n = 0; n < 2; ++n) _Pragma("unroll") for (int k = 0; k < 2; ++k) \
        acc[ai][bj][m][n] = __builtin_amdgcn_mfma_f32_16x16x32_bf16(Bt[n][k], At[m][k], acc[ai][bj][m][n], 0, 0, 0); __builtin_amdgcn_s_setprio(0); } while (0)
#define PG8_WAIT_V(n) asm volatile("s_waitcnt vmcnt(" #n ")" ::: "memory")
#define PG8_WAIT_L(n) asm volatile("s_waitcnt lgkmcnt(" #n ")" ::: "memory")
#define PG8_BAR __builtin_amdgcn_s_barrier()
#define PG8_SCHED __builtin_amdgcn_sched_barrier(0)
    Unit cur, nxt; int ui = 0;
    if (!S.next(0, cur)) return;
    f32x4 acc[2][2][4][2];
#pragma unroll
    for (int a = 0; a < 2; ++a)
#pragma unroll
        for (int b = 0; b < 2; ++b)
#pragma unroll
            for (int m = 0; m < 4; ++m)
#pragma unroll
                for (int n = 0; n < 2; ++n) acc[a][b][m][n] = (f32x4){0.f, 0.f, 0.f, 0.f};
    bf16x8 At[4][2], B0[2][2], B1[2][2];
    const char* cA = (const char*)g.A + (size_t)cur.pm * tstep; const char* cB = (const char*)g.Bt + (size_t)cur.pn * tstep;
    S.a_ready(cur);
    if constexpr (SP2) {
        PG8_STAGE(PG8_SB(0, 0), cB, voffB); PG8_STAGE(PG8_SB(0, 1), cB + hstep, voffB); PG8_STAGE(PG8_SA(0, 0), cA, voffA); PG8_STAGE(PG8_SA(0, 1), cA + hstep, voffA);
        if (wr == 1) PG8_BAR;
        PG8_WAIT_V(2); PG8_BAR;
        PG8_STAGE(PG8_SB(1, 0), cB + kstep, voffB); PG8_STAGE(PG8_SA(1, 0), cA + kstep, voffA); PG8_STAGE(PG8_SB(1, 1), cB + hstep + kstep, voffB);
        PG8_WAIT_V(6); PG8_BAR;
    } else {
        PG8_STAGE(PG8_SB(0, 0), cB, voffB); PG8_STAGE(PG8_SA(0, 0), cA, voffA); PG8_STAGE(PG8_SB(0, 1), cB + hstep, voffB); PG8_STAGE(PG8_SA(0, 1), cA + hstep, voffA);
        if (wr == 1) PG8_BAR;
        PG8_WAIT_V(4); PG8_BAR;
        PG8_STAGE(PG8_SB(1, 0), cB + kstep, voffB); PG8_STAGE(PG8_SA(1, 0), cA + kstep, voffA); PG8_STAGE(PG8_SB(1, 1), cB + hstep + kstep, voffB);
        PG8_WAIT_V(6); PG8_BAR;
    }
    for (;;) {
        const bool has_next = S.next(ui + 1, nxt);
        const char* nA = has_next ? (const char*)g.A + (size_t)nxt.pm * tstep : cA; const char* nB = has_next ? (const char*)g.Bt + (size_t)nxt.pn * tstep : cB;
        for (int t = 0; t < nt; t += 2) {
            const bool last = (t == nt - 2);
            const char* a1 = cA + (size_t)(t + 1) * kstep;
            const char* a2 = last ? nA : cA + (size_t)(t + 2) * kstep; const char* b2 = last ? nB : cB + (size_t)(t + 2) * kstep;
            const char* a3 = a2 + kstep; const char* b3 = b2 + kstep;
            if (last && has_next) S.a_ready(nxt);
            if constexpr (SP2) {
            PG8_LDB(B0, 0, 0); PG8_LDB(B1, 0, 1); PG8_SCHED; PG8_LDA(At, 0, 0); PG8_STAGE(PG8_SA(1, 1), a1 + hstep, voffA);
            PG8_WAIT_V(8); PG8_WAIT_L(0); PG8_BAR; PG8_MMA(0, 0, At, B0); PG8_MMA(0, 1, At, B1); PG8_BAR; PG8_SCHED;
            PG8_LDA(At, 0, 1); PG8_STAGE(PG8_SB(0, 0), b2, voffB); PG8_STAGE(PG8_SB(0, 1), b2 + hstep, voffB); PG8_STAGE(PG8_SA(0, 0), a2, voffA);
            PG8_WAIT_V(8); PG8_WAIT_L(0); PG8_BAR; PG8_MMA(1, 0, At, B0); PG8_MMA(1, 1, At, B1); PG8_BAR; PG8_SCHED;
            PG8_LDB(B0, 1, 0); PG8_LDB(B1, 1, 1); PG8_SCHED; PG8_LDA(At, 1, 0); PG8_STAGE(PG8_SA(0, 1), a2 + hstep, voffA);
            PG8_WAIT_V(8); PG8_WAIT_L(0); PG8_BAR; PG8_MMA(0, 0, At, B0); PG8_MMA(0, 1, At, B1); PG8_BAR; PG8_SCHED;
            PG8_LDA(At, 1, 1); PG8_STAGE(PG8_SB(1, 0), b3, voffB); PG8_STAGE(PG8_SB(1, 1), b3 + hstep, voffB); PG8_STAGE(PG8_SA(1, 0), a3, voffA);
            PG8_WAIT_V(8); PG8_WAIT_L(0); PG8_BAR; PG8_MMA(1, 0, At, B0); PG8_MMA(1, 1, At, B1); PG8_BAR; PG8_SCHED;
            } else {
            PG8_LDB(B0, 0, 0); PG8_SCHED; PG8_LDA(At, 0, 0); PG8_STAGE(PG8_SA(1, 1), a1 + hstep, voffA);
            PG8_WAIT_L(8); PG8_BAR; PG8_WAIT_L(0); PG8_MMA(0, 0, At, B0); PG8_BAR; PG8_SCHED;
            PG8_LDB(B1, 0, 1); PG8_STAGE(PG8_SB(0, 0), b2, voffB);
            PG8_BAR; PG8_WAIT_L(0); PG8_MMA(0, 1, At, B1); PG8_BAR;
            PG8_LDA(At, 0, 1); PG8_STAGE(PG8_SA(0, 0), a2, voffA);
            PG8_BAR; PG8_WAIT_L(0); PG8_MMA(1, 0, At, B0); PG8_BAR; PG8_SCHED;
            PG8_STAGE(PG8_SB(0, 1), b2 + hstep, voffB);
            PG8_WAIT_V(6); PG8_BAR; PG8_MMA(1, 1, At, B1); PG8_BAR;
            PG8_LDB(B0, 1, 0); PG8_SCHED; PG8_LDA(At, 1, 0); PG8_STAGE(PG8_SA(0, 1), a2 + hstep, voffA);
            PG8_WAIT_L(8); PG8_BAR; PG8_WAIT_L(0); PG8_MMA(0, 0, At, B0); PG8_BAR; PG8_SCHED;
            PG8_LDB(B1, 1, 1); PG8_STAGE(PG8_SB(1, 0), b3, voffB);
            PG8_BAR; PG8_WAIT_L(0); PG8_MMA(0, 1, At, B1); PG8_BAR;
            PG8_LDA(At, 1, 1); PG8_STAGE(PG8_SA(1, 0), a3, voffA);
            PG8_BAR; PG8_WAIT_L(0); PG8_MMA(1, 0, At, B0); PG8_BAR; PG8_SCHED;
            PG8_STAGE(PG8_SB(1, 1), b3 + hstep, voffB);
            PG8_WAIT_V(6); PG8_BAR; PG8_MMA(1, 1, At, B1); PG8_BAR;
            }
        }
        if constexpr (ALIGN_EPI) { if (wr == 0) PG8_BAR; }
        if constexpr (!Epi::AFTER_DRAIN) { E(acc, cur, wr, wc, fr, fq); S.done(cur); }
        if (!has_next) break;
#pragma unroll
        for (int a = 0; a < 2; ++a)
#pragma unroll
            for (int b = 0; b < 2; ++b)
#pragma unroll
                for (int m = 0; m < 4; ++m)
#pragma unroll
                    for (int n = 0; n < 2; ++n) acc[a][b][m][n] = (f32x4){0.f, 0.f, 0.f, 0.f};
        cur = nxt; cA = nA; cB = nB; ++ui;
        if constexpr (ALIGN_EPI) { if (wr == 1) PG8_BAR; }
    }
    PG8_WAIT_V(0);
    if constexpr (!ALIGN_EPI) { if (wr == 0) PG8_BAR; }
    PG8_BAR;
    if constexpr (Epi::AFTER_DRAIN) { E.fused(acc, cur, wr, wc, fr, fq, lds, wid, lane); S.done(cur); }
#undef PG8_SA
#undef PG8_SB
#undef PG8_STAGE
#undef PG8_LDA
#undef PG8_LDB
#undef PG8_MMA
#undef PG8_WAIT_V
#undef PG8_WAIT_L
#undef PG8_BAR
#undef PG8_SCHED
}
}


namespace att {
typedef short bf16x8 __attribute__((ext_vector_type(8)));
typedef short s16x4 __attribute__((ext_vector_type(4)));
typedef float f32x16 __attribute__((ext_vector_type(16)));
typedef unsigned u32x4 __attribute__((ext_vector_type(4)));
typedef LAS const char* lds_cptr;
constexpr int NSLOT = 3, KSLOT = 8192, VSLOT = 16384;
constexpr int LDS_K = 0, LDS_V = NSLOT * KSLOT, LDS_WS = LDS_V + NSLOT * VSLOT, LDS_OST = LDS_WS + 8 * 256, LDS_END = LDS_OST + 8 * 8192;
constexpr float THR = 8.0f;
__device__ __forceinline__ int crow(int r, int hi) { return (r & 3) + 8 * (r >> 2) + 4 * hi; }
__device__ __forceinline__ void glds16(const void* gsrc, unsigned lds_dst) { unsigned keep;
    asm volatile("s_mov_b32 %0, m0\n\ts_mov_b32 m0, %2\n\ts_nop 0\n\tglobal_load_lds_dwordx4 %1, off\n\ts_mov_b32 m0, %0" : "=&s"(keep) : "v"(gsrc), "s"(lds_dst) : "memory"); }
__device__ __forceinline__ s16x4 vtr(lds_cptr p) { typedef short v4i16_t __attribute__((ext_vector_type(4))); return __builtin_bit_cast(s16x4, __builtin_amdgcn_ds_read_tr16_b64_v4i16((LAS v4i16_t*)p)); }
__device__ __forceinline__ unsigned cvtpk(float lo, float hi) { typedef float f2 __attribute__((ext_vector_type(2))); typedef __bf16 b2 __attribute__((ext_vector_type(2))); f2 v = {lo, hi}; b2 b = __builtin_convertvector(v, b2); return __builtin_bit_cast(unsigned, b); }
__device__ __forceinline__ float swapmax(float m) { auto rr = __builtin_amdgcn_permlane32_swap(__float_as_uint(m), __float_as_uint(m), false, false); return fmaxf(__uint_as_float(rr[0]), __uint_as_float(rr[1])); }
__device__ __forceinline__ float swapadd(float m) { auto rr = __builtin_amdgcn_permlane32_swap(__float_as_uint(m), __float_as_uint(m), false, false); return __uint_as_float(rr[0]) + __uint_as_float(rr[1]); }
#define ATT_WAIT_BAR(N) asm volatile("s_waitcnt vmcnt(" #N ") lgkmcnt(0)\n\ts_barrier" ::: "memory")

__device__ __forceinline__ void attn_unit(int b, int h, int qb, bf16* QO, const bf16* __restrict__ Kb, const bf16* __restrict__ Vb, LAS unsigned char* lds, float lam, const float* head_norm) {
    const int tid = threadIdx.x, lane = tid & 63, r32 = lane & 31, hi = lane >> 5; const int wid = __builtin_amdgcn_readfirstlane(tid >> 6);
    const long rowbase = (long)b * SEQ; const int q0 = qb * 256;
    const int NT = 4 * qb + 4, tmax = 4 * qb + (wid >> 1);
    const unsigned lds0 = (unsigned)(uintptr_t)lds;
    LAS float* wsf = (LAS float*)(lds + LDS_WS) + wid * 64;
    LAS unsigned short* stash = (LAS unsigned short*)(lds + LDS_OST + wid * 8192);
    const bf16* Vh = Vb + rowbase * D + h * 128;
    const bf16* vsrc1 = Vh + (long)(16 * (wid & 3) + (lane >> 2)) * D + (wid >> 2) * 32 + (lane & 3) * 8;
    const bf16* vsrc2 = vsrc1 + 64;
    const unsigned kdst = lds0 + LDS_K + wid * 1024, vdst1 = lds0 + LDS_V + wid * 1024, vdst2 = vdst1 + 8192;
    const lds_cptr kp0 = (lds_cptr)lds + LDS_K + hi * 1024 + r32 * 16;
    const lds_cptr vp0 = (lds_cptr)lds + LDS_V + ((lane >> 4) & 1) * 32 + (lane & 3) * 8 + (4 * hi + ((lane & 15) >> 2)) * 64;
#pragma unroll 1
    for (int c = 0; c < 2; ++c) {
        const bf16* ksrc = Kb + (rowbase + lane) * D + h * 128 + c * 64 + wid * 8;
#define ATT_DMA(t, slot) do { glds16(ksrc + (long)(t) * 64 * D, (unsigned)__builtin_amdgcn_readfirstlane(kdst + (slot) * KSLOT)); \
        glds16(vsrc1 + (long)(t) * 64 * D, (unsigned)__builtin_amdgcn_readfirstlane(vdst1 + (slot) * VSLOT)); glds16(vsrc2 + (long)(t) * 64 * D, (unsigned)__builtin_amdgcn_readfirstlane(vdst2 + (slot) * VSLOT)); } while (0)
        bf16x8 qr[4];
        { const bf16* Qw = QO + (rowbase + q0 + wid * 32 + r32) * D + h * 128 + c * 64 + hi * 8;
#pragma unroll
          for (int s = 0; s < 4; ++s) qr[s] = *(const bf16x8*)(Qw + s * 16); }
        ATT_DMA(0, 0); ATT_DMA(1, 1);
        float mhat = 0.f, l_reg = 0.f; f32x16 o[4]; f32x16 negm;
#pragma unroll
        for (int r = 0; r < 16; ++r) { negm[r] = 0.f; o[0][r] = 0.f; o[1][r] = 0.f; o[2][r] = 0.f; o[3][r] = 0.f; }
        int slot = 0;
#pragma unroll 1
        for (int t = 0; t < NT; ++t) {
            if (t + 1 < NT) ATT_WAIT_BAR(3); else ATT_WAIT_BAR(0);
            if (t + 2 < NT) { const int s2 = (slot >= 1) ? slot - 1 : 2; ATT_DMA(t + 2, s2); }
            if (t <= tmax) {
                f32x16 p0, p1;
                { const lds_cptr kb = kp0 + slot * KSLOT;
#pragma unroll
                  for (int s = 0; s < 4; ++s) { const bf16x8 b0 = *(const LAS bf16x8*)(kb + s * 2048), b1 = *(const LAS bf16x8*)(kb + s * 2048 + 512);
                      if (s == 0) { p0 = __builtin_amdgcn_mfma_f32_32x32x16_bf16(b0, qr[0], negm, 0, 0, 0); p1 = __builtin_amdgcn_mfma_f32_32x32x16_bf16(b1, qr[0], negm, 0, 0, 0); }
                      else { p0 = __builtin_amdgcn_mfma_f32_32x32x16_bf16(b0, qr[s], p0, 0, 0, 0); p1 = __builtin_amdgcn_mfma_f32_32x32x16_bf16(b1, qr[s], p1, 0, 0, 0); } } }
                float rm = fmaxf(p0[0], p1[0]);
#pragma unroll
                for (int r = 1; r < 16; ++r) rm = fmaxf(rm, fmaxf(p0[r], p1[r]));
                rm = swapmax(rm);
                if (t == 0 || __any(rm > THR)) {
                    const float dl = (t == 0) ? rm : fmaxf(rm, 0.f); mhat += dl;
#pragma unroll
                    for (int r = 0; r < 16; ++r) { p0[r] -= dl; p1[r] -= dl; negm[r] = -mhat; }
                    if (t != 0) { const float f = __builtin_amdgcn_exp2f(-dl); l_reg *= f; if (hi == 0) wsf[r32] = f;
                        asm volatile("s_waitcnt lgkmcnt(0)" ::: "memory");
#pragma unroll
                        for (int r = 0; r < 16; ++r) { const float fr = wsf[crow(r, hi)]; o[0][r] *= fr; o[1][r] *= fr; o[2][r] *= fr; o[3][r] *= fr; }
                        asm volatile("s_waitcnt lgkmcnt(0)" ::: "memory"); }
                }
                float sacc = 0.f;
#pragma unroll
                for (int r = 0; r < 16; ++r) { p0[r] = __builtin_amdgcn_exp2f(p0[r]); p1[r] = __builtin_amdgcn_exp2f(p1[r]); sacc += p0[r] + p1[r]; }
                l_reg += sacc;
                u32x4 pw[4];
#pragma unroll
                for (int k = 0; k < 2; ++k) { pw[k] = (u32x4){cvtpk(p0[8 * k], p0[8 * k + 1]), cvtpk(p0[8 * k + 2], p0[8 * k + 3]), cvtpk(p0[8 * k + 4], p0[8 * k + 5]), cvtpk(p0[8 * k + 6], p0[8 * k + 7])};
                    pw[2 + k] = (u32x4){cvtpk(p1[8 * k], p1[8 * k + 1]), cvtpk(p1[8 * k + 2], p1[8 * k + 3]), cvtpk(p1[8 * k + 4], p1[8 * k + 5]), cvtpk(p1[8 * k + 6], p1[8 * k + 7])}; }
                { const lds_cptr vp = vp0 + slot * VSLOT;
#pragma unroll
                  for (int db = 0; db < 4; ++db)
#pragma unroll
                      for (int ks = 0; ks < 4; ++ks) { const s16x4 lo = vtr(vp + db * 4096 + ks * 1024), hh = vtr(vp + db * 4096 + ks * 1024 + 512);
                          const bf16x8 vf = (bf16x8){lo[0], lo[1], lo[2], lo[3], hh[0], hh[1], hh[2], hh[3]};
                          o[db] = __builtin_amdgcn_mfma_f32_32x32x16_bf16(__builtin_bit_cast(bf16x8, pw[ks]), vf, o[db], 0, 0, 0); } }
            }
            slot = (slot == 2) ? 0 : slot + 1;
        }
        asm volatile("s_waitcnt lgkmcnt(0)\n\ts_barrier" ::: "memory");
        const float ltot = swapadd(l_reg);
        if (hi == 0) wsf[32 + r32] = 1.0f / ltot;
        asm volatile("s_waitcnt lgkmcnt(0)" ::: "memory");
        float rli[16];
#pragma unroll
        for (int r = 0; r < 16; ++r) rli[r] = wsf[32 + crow(r, hi)];
        asm volatile("s_waitcnt lgkmcnt(0)" ::: "memory");
        if (c == 0) {
#pragma unroll
            for (int r = 0; r < 16; ++r) { const int orow = crow(r, hi);
#pragma unroll
                for (int db = 0; db < 4; ++db) stash[orow * 128 + db * 32 + r32] = (unsigned short)f2bf(o[db][r] * rli[r]); }
            asm volatile("s_waitcnt lgkmcnt(0)" ::: "memory");
        } else {
            float ss[16];
#pragma unroll
            for (int r = 0; r < 16; ++r) { const int orow = crow(r, hi); float a = 0.f;
#pragma unroll
                for (int db = 0; db < 4; ++db) { const float v = bf2f(stash[orow * 128 + db * 32 + r32]) - lam * (o[db][r] * rli[r]); o[db][r] = v; a += v * v; }
                ss[r] = a; }
#pragma unroll
            for (int r = 0; r < 16; ++r) { float a = ss[r]; a += __shfl_xor(a, 1); a += __shfl_xor(a, 2); a += __shfl_xor(a, 4); a += __shfl_xor(a, 8); a += __shfl_xor(a, 16);
                ss[r] = (1.0f - LAM_INIT) / sqrtf(a * (1.0f / 128.0f) + EPS); }
            float hn[4];
#pragma unroll
            for (int db = 0; db < 4; ++db) hn[db] = head_norm[db * 32 + r32];
            asm volatile("s_waitcnt lgkmcnt(0)" ::: "memory");
#pragma unroll
            for (int r = 0; r < 16; ++r) { const int orow = crow(r, hi);
#pragma unroll
                for (int db = 0; db < 4; ++db) stash[orow * 128 + db * 32 + r32] = (unsigned short)f2bf(o[db][r] * ss[r] * hn[db]); }
            asm volatile("s_waitcnt lgkmcnt(0)" ::: "memory");
            bf16* Ow = QO + (rowbase + q0 + wid * 32) * D + h * 128;
#pragma unroll
            for (int i = 0; i < 8; ++i) { const int row = i * 4 + (lane >> 4), ch = lane & 15; const u32x4 v = *(const LAS u32x4*)(stash + row * 128 + ch * 8); *(u32x4*)(Ow + (long)row * D + ch * 8) = v; }
            asm volatile("s_waitcnt lgkmcnt(0)" ::: "memory");
        }
#undef ATT_DMA
    }
}
}
constexpr int NG_LD = 132, NG_TLD = 129;
template <class Epi>
__device__ __forceinline__ void ngemm(LAS unsigned char* lds, const bf16* A, int lda, const bf16* B, int sbk, int sbn, int Mr, int Nc, int Kd, const Epi& epi, int vcu, int G) {
    LAS float* As = (LAS float*)lds; LAS float* Bs = As + 16 * NG_LD; LAS float* T = Bs + 16 * NG_LD;
    const int tid = threadIdx.x, ty = tid >> 4, tx = tid & 15;
    const int nTn = Nc / 128, nT = (Mr / 128) * nTn;
    for (int tile = vcu; tile < nT; tile += G) {
        const int tm = tile / nTn, tn = tile % nTn;
        float acc[4][8];
#pragma unroll
        for (int i = 0; i < 4; ++i)
#pragma unroll
            for (int j = 0; j < 8; ++j) acc[i][j] = 0.f;
        const int lr = tid >> 2, lk = (tid & 3) * 4;
        for (int k0 = 0; k0 < Kd; k0 += 16) {
            { const bf16* ap = A + (size_t)(tm * 128 + lr) * lda + k0 + lk;
#pragma unroll
              for (int j = 0; j < 4; ++j) As[(lk + j) * NG_LD + lr] = bf2f(ap[j]); }
            { const bf16* bp = B + (size_t)(k0 + lk) * sbk + (size_t)(tn * 128 + lr) * sbn;
#pragma unroll
              for (int j = 0; j < 4; ++j) Bs[(lk + j) * NG_LD + lr] = bf2f(bp[(size_t)j * sbk]); }
            __syncthreads();
#pragma unroll
            for (int kk = 0; kk < 16; ++kk) {
                const f32x4 a = *(const LAS f32x4*)(As + kk * NG_LD + ty * 4);
                const f32x4 b0 = *(const LAS f32x4*)(Bs + kk * NG_LD + tx * 8), b1 = *(const LAS f32x4*)(Bs + kk * NG_LD + tx * 8 + 4);
#pragma unroll
                for (int i = 0; i < 4; ++i) {
#pragma unroll
                    for (int j = 0; j < 4; ++j) { acc[i][j] += a[i] * b0[j]; acc[i][4 + j] += a[i] * b1[j]; }
                }
            }
            __syncthreads();
        }
#pragma unroll
        for (int i = 0; i < 4; ++i)
#pragma unroll
            for (int j = 0; j < 8; ++j) T[(ty * 4 + i) * NG_TLD + tx * 8 + j] = acc[i][j];
        __syncthreads();
        for (int idx = tid; idx < 128 * 128; idx += 512) { const int r = idx >> 7, c = idx & 127; epi(tm * 128 + r, tn * 128 + c, T, r, c); }
        __syncthreads();
    }
}
__device__ __forceinline__ float sigmoidf_(float v) { return 1.0f / (1.0f + __expf(-v)); }
__device__ __forceinline__ float gelu_tanh(float x) { const float u = 0.7978845608028654f * (x + 0.044715f * x * x * x); return x / (1.0f + __expf(-2.0f * u)); }

struct EpiStore { bf16* O; int ld; float scale;
    __device__ __forceinline__ void operator()(int row, int col, const LAS float* T, int r, int c) const { O[(size_t)row * ld + col] = (bf16)f2bf(T[r * NG_TLD + c] * scale); } };
struct EpiStoreF32 { float* O; int ld;
    __device__ __forceinline__ void operator()(int row, int col, const LAS float* T, int r, int c) const { O[(size_t)row * ld + col] = T[r * NG_TLD + c]; } };
struct EpiInProj { bf16 *U, *Q, *K, *V, *Gt; const float *cosT, *sinT, *bgate;
    __device__ __forceinline__ void operator()(int row, int col, const LAS float* T, int r, int c) const {
        const float v = T[r * NG_TLD + c];
        if (col < 1024) { U[(size_t)row * D + col] = (bf16)f2bf(v); return; }
        if (col < 3072) { const int cc = (col - 1024) & 1023, d = cc & 63, i = d & 31, pos = row & (SEQ - 1);
            const float cs = cosT[pos * 32 + i], sn = sinT[pos * 32 + i];
            const float o = (d < 32) ? (v * cs - T[r * NG_TLD + c + 32] * sn) : (v * cs + T[r * NG_TLD + c - 32] * sn);
            if (col < 2048) Q[(size_t)row * D + cc] = (bf16)f2bf(o * QSCALE); else K[(size_t)row * D + cc] = (bf16)f2bf(o);
            return; }
        if (col < 4096) { V[(size_t)row * D + (col - 3072)] = (bf16)f2bf(v); return; }
        Gt[(size_t)row * 2048 + (col - 4096)] = (bf16)f2bf(sigmoidf_(v + bgate[col - 4096]));
    } };
struct EpiGlu { const bf16* YS; bf16* O; const float* bglu;
    __device__ __forceinline__ void operator()(int row, int col, const LAS float* T, int r, int c) const {
        const float t = T[r * NG_TLD + c] + bglu[col]; const float ys = bf2f(YS[(size_t)row * D + col]);
        O[(size_t)row * D + col] = (bf16)f2bf(ys * sigmoidf_(t)); } };
struct EpiMergeA { const bf16* Gt; float* TMP;
    __device__ __forceinline__ void operator()(int row, int col, const LAS float* T, int r, int c) const {
        TMP[(size_t)row * D + col] = bf2f(Gt[(size_t)row * 2048 + col]) * T[r * NG_TLD + c]; } };
struct EpiMergeB { const bf16* Gt; const float* TMP; bf16* O;
    __device__ __forceinline__ void operator()(int row, int col, const LAS float* T, int r, int c) const {
        O[(size_t)row * D + col] = (bf16)f2bf(TMP[(size_t)row * D + col] + bf2f(Gt[(size_t)row * 2048 + 1024 + col]) * T[r * NG_TLD + c]); } };
struct EpiGateN { bf16* Gt; const float* bgate;
    __device__ __forceinline__ void operator()(int row, int col, const LAS float* T, int r, int c) const { Gt[(size_t)row * 2048 + col] = (bf16)f2bf(sigmoidf_(T[r * NG_TLD + c] + bgate[col])); } };
struct EpiRelu2 { bf16* O; int ld;
    __device__ __forceinline__ void operator()(int row, int col, const LAS float* T, int r, int c) const { const float v = fmaxf(T[r * NG_TLD + c], 0.f); O[(size_t)row * ld + col] = (bf16)f2bf(v * v); } };

typedef const __attribute__((address_space(4))) Args* KArgP;
__device__ __forceinline__ KArgP late_args() { KArgP p = (KArgP)__builtin_amdgcn_kernarg_segment_ptr(); asm volatile("" : "+s"(p)); return p; }
#define INP(k) ((const float*)late_args()->in[k])
__global__ void __launch_bounds__(NWAVES * 64, 2) mk_fwd(Args args) {
    extern __shared__ __attribute__((aligned(16))) unsigned char lds_raw[];
    LAS unsigned char* lds = (LAS unsigned char*)lds_raw;
    volatile LAS unsigned* MISC = (volatile LAS unsigned*)(lds + MISC_OFF);
    const int tid = threadIdx.x, lane = tid & 63, wave = __builtin_amdgcn_readfirstlane(tid >> 6);
    const int G = gridDim.x; const int bx = blockIdx.x; const int vcu = (G % 8 == 0) ? (bx % 8) * (G / 8) + bx / 8 : bx;
    unsigned char* ws = args.ws;
    gu32* ctl = (gu32*)(ws + WS_CTL);
    for (int u = tid; u < (LDS_BYTES - LDSCTL_OFF) / 4; u += NWAVES * 64) ((LAS unsigned*)(lds + LDSCTL_OFF))[u] = 0u;
    __syncthreads();
    XcdBarrier bar; bar.bar = (unsigned*)(ctl + CW_BAR); bar.x = 0; bar.st = nullptr;
    if (MK_N_LAUNCHES == 1) bar = xcd_barrier_post((unsigned*)(ctl + CW_BAR), MISC + 8);
    const int lo = args.ph_lo, hi = args.ph_hi;
#define IN(k) (lo <= (k) && (k) < hi)
#define SEAM(k) do { if (IN(k) && IN((k) + 1)) xcd_barrier(bar); } while (0)

    float* out = late_args()->out;
    float* scal = (float*)(ws + WS_SCAL); float* lamb = (float*)(ws + WS_SSMP); float* bbar = lamb + SG * SP * 4;
    float* cosT = (float*)(ws + WS_COS); float* sinT = (float*)(ws + WS_SIN);
    bf16* MEMN = (bf16*)(ws + WS_MEMN); bf16* KVM = (bf16*)(ws + WS_KVM);
    bf16* Win = (bf16*)(ws + WS_WIN); bf16* Wglu = (bf16*)(ws + WS_WGLU); bf16* Wssm = (bf16*)(ws + WS_WSSM); bf16* Wda = (bf16*)(ws + WS_WDA); bf16* Wmix = (bf16*)(ws + WS_WMIX);
    bf16* Wxq = (bf16*)(ws + WS_WXQ); bf16* Wxo = (bf16*)(ws + WS_WXO); bf16* Wxkv = (bf16*)(ws + WS_WXKV); bf16* Wf1 = (bf16*)(ws + WS_WF1); bf16* Wf2 = (bf16*)(ws + WS_WF2);
    bf16* HB = (bf16*)(ws + WS_H); bf16* UB = (bf16*)(ws + WS_U); bf16* QB = (bf16*)(ws + WS_Q); bf16* KB = (bf16*)(ws + WS_K); bf16* VB = (bf16*)(ws + WS_V);
    bf16* GT = (bf16*)out;
    float* EB = (float*)(ws + WS_E); float* SINB = (float*)(ws + WS_SIN_C);
    const int gw = vcu * NWAVES + wave, NGW = G * NWAVES;

    if (IN(0)) { const float* x = INP(0); const float* mem = INP(1); const float* g_mix_pre = INP(2); const float* w_in = INP(3); const float* lam_re = INP(5); const float* lam_im = INP(6); const float* log_dt = INP(7); const float* sb_re = INP(8); const float* sb_im = INP(9); const float* w_glu = INP(13); const float* w_ssm = INP(15); const float* lq1 = INP(16); const float* lk1 = INP(17); const float* lq2 = INP(18); const float* lk2 = INP(19); const float* w_da = INP(21); const float* w_mix = INP(22); const float* g_mem = INP(25); const float* w_xq = INP(26); const float* w_xkv = INP(27); const float* w_xo = INP(28); const float* w_ff1 = INP(31); const float* w_ff2 = INP(32);
#ifdef DELAY_TEST
        { const unsigned long long t0 = __builtin_amdgcn_s_memrealtime(); while (__builtin_amdgcn_s_memrealtime() - t0 < (unsigned long long)DELAY_TEST) __builtin_amdgcn_s_sleep(10); }
#endif
#ifdef SCRIBBLE_TEST
        for (size_t i = (size_t)bx * 512 + tid; i < (size_t)M * D / 4; i += (size_t)G * 512) ((GAS f32x4*)out)[i] = (f32x4){1.0f, 2.0f, 3.0f, 4.0f};
#endif
        LAS float* scr = (LAS float*)(lds + wave * 16384);
        constexpr int I_IN = 16 * 192, I_SQ = 16 * 32, I_KV = 16 * 64, I_F1 = 16 * 128, I_F2 = 64 * 32;
        constexpr int NITEMS = I_IN + 6 * I_SQ + I_KV + I_F1 + I_F2;
        for (int it = gw; it < NITEMS; it += NGW) {
            int r = it;
            if (r < I_IN) { p0_transpose_item<FAST(0) != 0>(w_in, D, INC, Win, scr, r, lane); continue; } r -= I_IN;
            if (r < I_SQ) { p0_transpose_item<false>(w_glu, D, D, Wglu, scr, r, lane); continue; } r -= I_SQ;
            if (r < I_SQ) { p0_transpose_item<false>(w_ssm, D, D, Wssm, scr, r, lane); continue; } r -= I_SQ;
            if (r < I_SQ) { p0_transpose_item<false>(w_da, D, D, Wda, scr, r, lane); continue; } r -= I_SQ;
            if (r < I_SQ) { p0_transpose_item<false>(w_mix, D, D, Wmix, scr, r, lane); continue; } r -= I_SQ;
            if (r < I_SQ) { p0_transpose_item<false>(w_xq, D, D, Wxq, scr, r, lane); continue; } r -= I_SQ;
            if (r < I_SQ) { p0_transpose_item<false>(w_xo, D, D, Wxo, scr, r, lane); continue; } r -= I_SQ;
            if (r < I_KV) { p0_transpose_item<false>(w_xkv, D, 2 * D, Wxkv, scr, r, lane); continue; } r -= I_KV;
            if (r < I_F1) { p0_transpose_item<false>(w_ff1, D, FF, Wf1, scr, r, lane); continue; } r -= I_F1;
            p0_transpose_item<false>(w_ff2, FF, D, Wf2, scr, r, lane);
        }
        for (int m = gw; m < M; m += NGW) rms_row_to_bf16(x + (size_t)m * D, g_mix_pre, HB + (size_t)m * D, lane);
        for (int m = gw; m < MM; m += NGW) rms_row_to_bf16(mem + (size_t)m * D, g_mem, MEMN + (size_t)m * D, lane);
        for (int idx = vcu * 512 + tid; idx < SEQ * 32; idx += G * 512) { const int pos = idx >> 5, i = idx & 31; float c, s; sincos_reduced((double)pos * rope_inv(i), c, s); cosT[idx] = c; sinT[idx] = s; }
        for (int idx = vcu * 512 + tid; idx < SG * SP; idx += G * 512) {
            const int g = idx >> 6;
            const double lr = (double)lam_re[idx], li = (double)lam_im[idx], dt = exp((double)log_dt[g]);
            const double zr = lr * dt, zi = li * dt;
            float c1, s1; sincos_reduced(zi, c1, s1);
            const double er = exp(zr), br = er * (double)c1, bi = er * (double)s1;
            float c64, s64; sincos_reduced(64.0 * zi, c64, s64);
            const double e64 = exp(64.0 * zr);
            lamb[idx * 4 + 0] = (float)br; lamb[idx * 4 + 1] = (float)bi; lamb[idx * 4 + 2] = (float)(e64 * (double)c64); lamb[idx * 4 + 3] = (float)(e64 * (double)s64);
            const double nr = br - 1.0, ni = bi, den = lr * lr + li * li;
            const double fr = (nr * lr + ni * li) / den, fi = (ni * lr - nr * li) / den;
            for (int h = 0; h < SH; ++h) { const double b_r = (double)sb_re[idx * SH + h], b_i = (double)sb_im[idx * SH + h];
                bbar[idx * 32 + h] = (float)(fr * b_r - fi * b_i); bbar[idx * 32 + 16 + h] = (float)(fr * b_i + fi * b_r); }
        }
        if (vcu == 0 && wave == 0) {
            const float a = wave_sum(lq1[lane] * lk1[lane]), b = wave_sum(lq2[lane] * lk2[lane]);
            if (lane == 0) scal[0] = expf(a) - expf(b) + LAM_INIT;
        }
    }
    SEAM(0);
    if (IN(1)) { const float* b_gate = INP(4);
#ifdef SCRIBBLE_TEST
        { unsigned bad = 0;
          for (size_t i = (size_t)bx * 512 + tid; i < (size_t)M * D / 4; i += (size_t)G * 512) { const f32x4 v = ((const GAS f32x4*)out)[i]; bad |= (v[0] != 1.0f) | (v[1] != 2.0f) | (v[2] != 3.0f) | (v[3] != 4.0f); }
          if (bad) __hip_atomic_store(ctl + 8, 1u, RLX_AGENT);
          __syncthreads(); }
#endif

#if FAST(0)
        { pg8::Gemm g{HB, Win, M, INC, D}; pg8::StaticOrder S; S.init(M, INC, G, bx);
          pg8::EpiInProjF e{UB, QB, KB, VB, GT, cosT, sinT, b_gate, QSCALE};
          pg8::gemm_phase<pg8::EpiInProjF, pg8::StaticOrder, true, true>(lds, g, S, e); }
#if FAST(9)
        { pg8::Gemm g{MEMN, Wxkv, MM, 2 * D, D}; pg8::StaticOrder S; S.init(MM, 2 * D, G, bx);
          pg8::EpiBf16<0> e{KVM, 2 * D, 1.0f};
          pg8::gemm_phase<pg8::EpiBf16<0>, pg8::StaticOrder, true, true>(lds, g, S, e); }
#else
        { EpiStore e2{KVM, 2 * D, 1.0f}; ngemm(lds, MEMN, D, Wxkv, 1, D, MM, 2 * D, D, e2, vcu, G); }
#endif
#else
        EpiInProj e{UB, QB, KB, VB, GT, cosT, sinT, b_gate};
        ngemm(lds, HB, D, Win, 1, D, M, INC, D, e, vcu, G);
        EpiStore e2{KVM, 2 * D, 1.0f};
        ngemm(lds, MEMN, D, Wxkv, 1, D, MM, 2 * D, D, e2, vcu, G);
#endif

    }
    SEAM(1);
    if (IN(2)) {
        for (int unit = gw; unit < BATCH * SG * NCH; unit += NGW) {
            const int c = unit % NCH, g = (unit / NCH) % SG, b = unit / (NCH * SG);
            const int gp = g * SP + lane;
            const float lbr = lamb[gp * 4 + 0], lbi = lamb[gp * 4 + 1];
            float br[16], bi[16];
#pragma unroll
            for (int h = 0; h < 16; ++h) { br[h] = bbar[gp * 32 + h]; bi[h] = bbar[gp * 32 + 16 + h]; }
            float xr = 0.f, xi = 0.f;
            const bf16* up = UB + (size_t)(b * SEQ + c * CH) * D + g * SH;
            for (int t = 0; t < CH; ++t) {
                const v4u w0 = *(const GAS v4u*)(up + (size_t)t * D), w1 = *(const GAS v4u*)(up + (size_t)t * D + 8);
                const float u[16] = {bflo(w0.x), bfhi(w0.x), bflo(w0.y), bfhi(w0.y), bflo(w0.z), bfhi(w0.z), bflo(w0.w), bfhi(w0.w), bflo(w1.x), bfhi(w1.x), bflo(w1.y), bfhi(w1.y), bflo(w1.z), bfhi(w1.z), bflo(w1.w), bfhi(w1.w)};
                float ar = 0.f, ai = 0.f;
#pragma unroll
                for (int h = 0; h < 16; ++h) { ar += br[h] * u[h]; ai += bi[h] * u[h]; }
                const float nr = lbr * xr - lbi * xi + ar, ni = lbr * xi + lbi * xr + ai; xr = nr; xi = ni;
            }
            float* e = EB + ((size_t)((b * SG + g) * NCH + c) * SP + lane) * 2; e[0] = xr; e[1] = xi;
        }
    }
    SEAM(2);
    if (IN(3)) {
        for (int idx = vcu * 512 + tid; idx < BATCH * SG * SP; idx += G * 512) {
            const int p = idx & 63, g = (idx >> 6) & 63, b = idx >> 12; const int gp = g * SP + p;
            const float tr = lamb[gp * 4 + 2], ti = lamb[gp * 4 + 3];
            float sr = 0.f, si = 0.f;
            const size_t base = ((size_t)(b * SG + g) * NCH) * SP + p;
            for (int c = 0; c < NCH; ++c) {
                const size_t o = (base + (size_t)c * SP) * 2;
                SINB[o] = sr; SINB[o + 1] = si;
                const float er = EB[o], ei = EB[o + 1];
                const float nr = tr * sr - ti * si + er, ni = tr * si + ti * sr + ei; sr = nr; si = ni;
            }
        }
    }
    SEAM(3);
    if (IN(4)) { const float* sc_re = INP(10); const float* sc_im = INP(11); const float* ssm_d = INP(12);
        LAS float* xs = (LAS float*)(lds + wave * 1024);
        for (int unit = gw; unit < BATCH * SG * NCH; unit += NGW) {
            const int c = unit % NCH, g = (unit / NCH) % SG, b = unit / (NCH * SG);
            const int gp = g * SP + lane;
            const float lbr = lamb[gp * 4 + 0], lbi = lamb[gp * 4 + 1];
            float br[16], bi[16], cr[16], ci[16];
#pragma unroll
            for (int h = 0; h < 16; ++h) { br[h] = bbar[gp * 32 + h]; bi[h] = bbar[gp * 32 + 16 + h]; }
            const int hh = lane & 15, pq = lane >> 4;
#pragma unroll
            for (int j = 0; j < 16; ++j) { cr[j] = sc_re[(size_t)(g * SH + hh) * SP + pq * 16 + j]; ci[j] = sc_im[(size_t)(g * SH + hh) * SP + pq * 16 + j]; }
            const float dsk = ssm_d[g * SH + hh];
            const float* sp = SINB + ((size_t)((b * SG + g) * NCH + c) * SP + lane) * 2;
            float xr = sp[0], xi = sp[1];
            const bf16* up = UB + (size_t)(b * SEQ + c * CH) * D + g * SH;
            bf16* yp = HB + (size_t)(b * SEQ + c * CH) * D + g * SH;
            for (int t = 0; t < CH; ++t) {
                const v4u w0 = *(const GAS v4u*)(up + (size_t)t * D), w1 = *(const GAS v4u*)(up + (size_t)t * D + 8);
                const float u[16] = {bflo(w0.x), bfhi(w0.x), bflo(w0.y), bfhi(w0.y), bflo(w0.z), bfhi(w0.z), bflo(w0.w), bfhi(w0.w), bflo(w1.x), bfhi(w1.x), bflo(w1.y), bfhi(w1.y), bflo(w1.z), bfhi(w1.z), bflo(w1.w), bfhi(w1.w)};
                float ar = 0.f, ai = 0.f;
#pragma unroll
                for (int h = 0; h < 16; ++h) { ar += br[h] * u[h]; ai += bi[h] * u[h]; }
                const float nr = lbr * xr - lbi * xi + ar, ni = lbr * xi + lbi * xr + ai; xr = nr; xi = ni;
                xs[lane] = xr; xs[64 + lane] = xi;
                LDS_WAIT(); asm volatile("" ::: "memory");
                float y = 0.f;
#pragma unroll
                for (int j = 0; j < 16; ++j) y += cr[j] * xs[pq * 16 + j] - ci[j] * xs[64 + pq * 16 + j];
                y += __shfl_xor(y, 16); y += __shfl_xor(y, 32);
                float uh = u[0];
#pragma unroll
                for (int h = 1; h < 16; ++h) uh = (hh == h) ? u[h] : uh;
                y += dsk * uh;
                if (lane < 16) yp[(size_t)t * D + hh] = (bf16)f2bf(gelu_tanh(y));
                LDS_WAIT(); asm volatile("" ::: "memory");
            }
        }
    }
    SEAM(4);
    if (IN(5)) { const float* head_norm = INP(20);
#if FAST(10)
        { static_assert(att::LDS_END <= LDSCTL_OFF, "attention LDS map");
          const float lam = __builtin_bit_cast(float, __hip_atomic_load((unsigned*)scal, RLX_AGENT));
          const int bh = vcu >> 4, s = vcu & 15;
          att::attn_unit(bh >> 3, bh & 7, 31 - s, QB, KB, VB, lds, lam, head_norm);
          att::attn_unit(bh >> 3, bh & 7, s, QB, KB, VB, lds, lam, head_norm); }
#else
        const float lam = scal[0];
        const int row = tid >> 3, sl = tid & 7;
        for (int i = 0; i < 8; ++i) {
            const int slot = (i & 1) ? (i * 256 + 255 - vcu) : (i * 256 + vcu);
            if (slot >= BATCH * 8 * 128) break;
            const int qc = 127 - (slot >> 4), bh = slot & 15, b = bh >> 3, h = bh & 7;
            const size_t rbase = (size_t)b * SEQ;
            const bf16* qp = QB + (rbase + qc * 64 + row) * D + h * 128;
            v4u q1p[8], q2p[8];
#pragma unroll
            for (int c8 = 0; c8 < 8; ++c8) { q1p[c8] = *(const GAS v4u*)(qp + c8 * 8); q2p[c8] = *(const GAS v4u*)(qp + 64 + c8 * 8); }
            float o1[16], o2[16]; float m1 = -1e30f, m2 = -1e30f, l1 = 0.f, l2 = 0.f;
#pragma unroll
            for (int j = 0; j < 16; ++j) { o1[j] = 0.f; o2[j] = 0.f; }
            const int nk = 64 * (qc + 1);
            for (int j = 0; j < nk; ++j) {
                const bf16* kp = KB + (rbase + j) * D + h * 128; const bf16* vp = VB + (rbase + j) * D + h * 128 + sl * 16;
                float s1 = 0.f, s2 = 0.f;
#pragma unroll
                for (int c8 = 0; c8 < 8; ++c8) { const v4u w = *(const GAS v4u*)(kp + c8 * 8); const v4u q = q1p[c8];
                    s1 += bflo(q.x) * bflo(w.x) + bfhi(q.x) * bfhi(w.x) + bflo(q.y) * bflo(w.y) + bfhi(q.y) * bfhi(w.y) + bflo(q.z) * bflo(w.z) + bfhi(q.z) * bfhi(w.z) + bflo(q.w) * bflo(w.w) + bfhi(q.w) * bfhi(w.w); }
#pragma unroll
                for (int c8 = 0; c8 < 8; ++c8) { const v4u w = *(const GAS v4u*)(kp + 64 + c8 * 8); const v4u q = q2p[c8];
                    s2 += bflo(q.x) * bflo(w.x) + bfhi(q.x) * bfhi(w.x) + bflo(q.y) * bflo(w.y) + bfhi(q.y) * bfhi(w.y) + bflo(q.z) * bflo(w.z) + bfhi(q.z) * bfhi(w.z) + bflo(q.w) * bflo(w.w) + bfhi(q.w) * bfhi(w.w); }
                const v4u v0 = *(const GAS v4u*)vp, v1 = *(const GAS v4u*)(vp + 8);
                const float vv[16] = {bflo(v0.x), bfhi(v0.x), bflo(v0.y), bfhi(v0.y), bflo(v0.z), bfhi(v0.z), bflo(v0.w), bfhi(v0.w), bflo(v1.x), bfhi(v1.x), bflo(v1.y), bfhi(v1.y), bflo(v1.z), bfhi(v1.z), bflo(v1.w), bfhi(v1.w)};
                { const float mn = fmaxf(m1, s1), a = __builtin_amdgcn_exp2f(m1 - mn), p = __builtin_amdgcn_exp2f(s1 - mn); m1 = mn; l1 = l1 * a + p;
#pragma unroll
                  for (int d = 0; d < 16; ++d) o1[d] = o1[d] * a + p * vv[d]; }
                { const float mn = fmaxf(m2, s2), a = __builtin_amdgcn_exp2f(m2 - mn), p = __builtin_amdgcn_exp2f(s2 - mn); m2 = mn; l2 = l2 * a + p;
#pragma unroll
                  for (int d = 0; d < 16; ++d) o2[d] = o2[d] * a + p * vv[d]; }
            }
            const float i1 = 1.0f / l1, i2 = lam / l2; float ss = 0.f;
#pragma unroll
            for (int d = 0; d < 16; ++d) { o1[d] = o1[d] * i1 - o2[d] * i2; ss += o1[d] * o1[d]; }
            ss += __shfl_xor(ss, 1); ss += __shfl_xor(ss, 2); ss += __shfl_xor(ss, 4);
            const float rs = (1.0f - LAM_INIT) / sqrtf(ss * (1.0f / 128.0f) + EPS);
            bf16* op = QB + (rbase + qc * 64 + row) * D + h * 128 + sl * 16;
            unsigned w[8];
#pragma unroll
            for (int d = 0; d < 8; ++d) w[d] = pk2(o1[2 * d] * rs * head_norm[sl * 16 + 2 * d], o1[2 * d + 1] * rs * head_norm[sl * 16 + 2 * d + 1]);
            *(GAS v4u*)op = (v4u){w[0], w[1], w[2], w[3]}; *(GAS v4u*)(op + 8) = (v4u){w[4], w[5], w[6], w[7]};
        }
#endif
    }
    SEAM(5);
    if (IN(6)) { const float* b_glu = INP(14);
#if FAST(1)
{ pg8::Gemm g{HB, Wglu, M, D, D}; pg8::StaticOrder S; S.init(M, D, G, bx); pg8::EpiGluF e{HB, UB, b_glu};
        pg8::gemm_phase<pg8::EpiGluF, pg8::StaticOrder, false, true>(lds, g, S, e); }
#else
{ EpiGlu e{HB, UB, b_glu}; ngemm(lds, HB, D, Wglu, 1, D, M, D, D, e, vcu, G); }
#endif
    }

    SEAM(6);
    if (IN(7)) {
#if FAST(2)
{ pg8::Gemm g{UB, Wssm, M, D, D}; pg8::StaticOrder S; S.init(M, D, G, bx); pg8::EpiMergeAF e{GT, (float*)KB};
        pg8::gemm_phase<pg8::EpiMergeAF, pg8::StaticOrder, false, true>(lds, g, S, e); }
#else
{ EpiMergeA e{GT, (float*)KB}; ngemm(lds, UB, D, Wssm, 1, D, M, D, D, e, vcu, G); }
#endif
    }

    SEAM(7);
    if (IN(8)) {
#if FAST(3)
{ pg8::Gemm g{QB, Wda, M, D, D}; pg8::StaticOrder S; S.init(M, D, G, bx); pg8::EpiMergeBF e{GT, (const float*)KB, UB};
        pg8::gemm_phase<pg8::EpiMergeBF, pg8::StaticOrder, false, true>(lds, g, S, e); }
#else
{ EpiMergeB e{GT, (const float*)KB, UB}; ngemm(lds, QB, D, Wda, 1, D, M, D, D, e, vcu, G); }
#endif
    }

    SEAM(8);
    if (IN(9)) {
#if FAST(4)
{ pg8::Gemm g{UB, Wmix, M, D, D}; pg8::StaticOrder S; S.init(M, D, G, bx); pg8::EpiBf16<0> e{QB, D, 1.0f};
        pg8::gemm_phase<pg8::EpiBf16<0>, pg8::StaticOrder, false, true>(lds, g, S, e); }
#else
{ EpiStore e{QB, D, 1.0f}; ngemm(lds, UB, D, Wmix, 1, D, M, D, D, e, vcu, G); }
#endif
    }

    SEAM(9);
    if (IN(10)) { const float* x = INP(0); const float* g_mix_post = INP(23); const float* g_x_pre = INP(24); for (int m = gw; m < M; m += NGW) resnorm_row(QB + (size_t)m * D, x + (size_t)m * D, g_mix_post, out + (size_t)m * D, g_x_pre, HB + (size_t)m * D, lane); }
    SEAM(10);
    if (IN(11)) {
#if FAST(5)
{ pg8::Gemm g{HB, Wxq, M, D, D}; pg8::StaticOrder S; S.init(M, D, G, bx); pg8::EpiBf16<0> e{UB, D, XSCALE};
        pg8::gemm_phase<pg8::EpiBf16<0>, pg8::StaticOrder, false, true>(lds, g, S, e); }
#else
{ EpiStore e{UB, D, XSCALE}; ngemm(lds, HB, D, Wxq, 1, D, M, D, D, e, vcu, G); }
#endif
    }

    SEAM(11);
    if (IN(12)) {
        LAS float* qs = (LAS float*)lds; LAS float* Ss = qs + 32 * 256;
        for (int unit = vcu; unit < BATCH * 4 * (SEQ / 32); unit += G) {
            const int rb = unit % (SEQ / 32), hd = (unit / (SEQ / 32)) & 3, b = unit / (4 * (SEQ / 32));
            const size_t r0 = (size_t)b * SEQ + rb * 32;
            for (int idx = tid; idx < 32 * 256; idx += 512) qs[idx] = bf2f(UB[(r0 + (idx >> 8)) * D + hd * 256 + (idx & 255)]);
            __syncthreads();
            const int row = tid >> 4, ks = tid & 15;
            for (int kk = 0; kk < 16; ++kk) {
                const int key = ks + 16 * kk; const bf16* kp = KVM + (size_t)(b * MEML + key) * 2048 + hd * 256;
                float s = 0.f;
                for (int d8 = 0; d8 < 32; ++d8) { const v4u w = *(const GAS v4u*)(kp + d8 * 8); const LAS float* q = qs + row * 256 + d8 * 8;
                    s += q[0] * bflo(w.x) + q[1] * bfhi(w.x) + q[2] * bflo(w.y) + q[3] * bfhi(w.y) + q[4] * bflo(w.z) + q[5] * bfhi(w.z) + q[6] * bflo(w.w) + q[7] * bfhi(w.w); }
                Ss[row * 256 + key] = s;
            }
            __syncthreads();
            { float mx = -1e30f;
              for (int kk = 0; kk < 16; ++kk) mx = fmaxf(mx, Ss[row * 256 + ks + 16 * kk]);
              mx = fmaxf(mx, __shfl_xor(mx, 1)); mx = fmaxf(mx, __shfl_xor(mx, 2)); mx = fmaxf(mx, __shfl_xor(mx, 4)); mx = fmaxf(mx, __shfl_xor(mx, 8));
              float sum = 0.f; float e[16];
#pragma unroll
              for (int kk = 0; kk < 16; ++kk) { e[kk] = __builtin_amdgcn_exp2f(Ss[row * 256 + ks + 16 * kk] - mx); sum += e[kk]; }
              sum += __shfl_xor(sum, 1); sum += __shfl_xor(sum, 2); sum += __shfl_xor(sum, 4); sum += __shfl_xor(sum, 8);
              const float inv = 1.0f / sum;
#pragma unroll
              for (int kk = 0; kk < 16; ++kk) Ss[row * 256 + ks + 16 * kk] = e[kk] * inv; }
            __syncthreads();
            { float o[16];
#pragma unroll
              for (int d = 0; d < 16; ++d) o[d] = 0.f;
              for (int mk = 0; mk < MEML; ++mk) { const float p = Ss[row * 256 + mk]; const bf16* vp = KVM + (size_t)(b * MEML + mk) * 2048 + 1024 + hd * 256 + ks * 16;
                  const v4u v0 = *(const GAS v4u*)vp, v1 = *(const GAS v4u*)(vp + 8);
                  o[0] += p * bflo(v0.x); o[1] += p * bfhi(v0.x); o[2] += p * bflo(v0.y); o[3] += p * bfhi(v0.y); o[4] += p * bflo(v0.z); o[5] += p * bfhi(v0.z); o[6] += p * bflo(v0.w); o[7] += p * bfhi(v0.w);
                  o[8] += p * bflo(v1.x); o[9] += p * bfhi(v1.x); o[10] += p * bflo(v1.y); o[11] += p * bfhi(v1.y); o[12] += p * bflo(v1.z); o[13] += p * bfhi(v1.z); o[14] += p * bflo(v1.w); o[15] += p * bfhi(v1.w); }
              bf16* op = QB + (r0 + row) * D + hd * 256 + ks * 16;
              *(GAS v4u*)op = (v4u){pk2(o[0], o[1]), pk2(o[2], o[3]), pk2(o[4], o[5]), pk2(o[6], o[7])};
              *(GAS v4u*)(op + 8) = (v4u){pk2(o[8], o[9]), pk2(o[10], o[11]), pk2(o[12], o[13]), pk2(o[14], o[15])}; }
            __syncthreads();
        }
    }
    SEAM(12);
    if (IN(13)) {
#if FAST(6)
{ pg8::Gemm g{QB, Wxo, M, D, D}; pg8::StaticOrder S; S.init(M, D, G, bx); pg8::EpiBf16<0> e{KB, D, 1.0f};
        pg8::gemm_phase<pg8::EpiBf16<0>, pg8::StaticOrder, false, true>(lds, g, S, e); }
#else
{ EpiStore e{KB, D, 1.0f}; ngemm(lds, QB, D, Wxo, 1, D, M, D, D, e, vcu, G); }
#endif
    }

    SEAM(13);
    if (IN(14)) { const float* g_x_post = INP(29); const float* g_ff_pre = INP(30); for (int m = gw; m < M; m += NGW) resnorm_row(KB + (size_t)m * D, out + (size_t)m * D, g_x_post, out + (size_t)m * D, g_ff_pre, HB + (size_t)m * D, lane); }
    SEAM(14);
    if (IN(15)) {
#if FAST(7)
{ pg8::Gemm g{HB, Wf1, M, FF, D}; pg8::StaticOrder S; S.init(M, FF, G, bx); pg8::EpiBf16<2> e{UB, FF, 1.0f};
        pg8::gemm_phase<pg8::EpiBf16<2>, pg8::StaticOrder, true, true>(lds, g, S, e); }
#else
{ EpiRelu2 e{UB, FF}; ngemm(lds, HB, D, Wf1, 1, D, M, FF, D, e, vcu, G); }
#endif
    }

    SEAM(15);
    if (IN(16)) {
#if FAST(8)
{ pg8::Gemm g{UB, Wf2, M, D, FF}; pg8::StaticOrder S; S.init(M, D, G, bx); pg8::EpiBf16<0> e{HB, D, 1.0f};
        pg8::gemm_phase<pg8::EpiBf16<0>, pg8::StaticOrder, false, true>(lds, g, S, e); }
#else
{ EpiStore e{HB, D, 1.0f}; ngemm(lds, UB, FF, Wf2, 1, FF, M, D, FF, e, vcu, G); }
#endif
    }

    SEAM(16);
    if (IN(17)) { const float* g_ff_post = INP(33); for (int m = gw; m < M; m += NGW) resnorm_row(HB + (size_t)m * D, out + (size_t)m * D, g_ff_post, out + (size_t)m * D, nullptr, nullptr, lane); }
#ifdef SCRIBBLE_TEST
    if (IN(17)) { VM_WAIT(); __syncthreads(); if (__hip_atomic_load(ctl + 8, RLX_AGENT) != 0u && bx == 0) { for (int i = tid; i < 4096; i += 512) out[i] = 1000.0f; } }
#endif
#undef IN
#undef SEAM
}

#ifdef RECOMP
__global__ void __launch_bounds__(NWAVES * 64, 2) recomp_kernel(Args args) {
    extern __shared__ __attribute__((aligned(16))) unsigned char lds_raw2[];
    LAS unsigned char* lds = (LAS unsigned char*)lds_raw2;
    const int G = gridDim.x; const int bx = blockIdx.x; const int vcu = (G % 8 == 0) ? (bx % 8) * (G / 8) + bx / 8 : bx;
    unsigned char* ws = args.ws;
    bf16* Win = (bf16*)(ws + WS_WIN); bf16* HB = (bf16*)(ws + WS_H); bf16* UB = (bf16*)(ws + WS_U); bf16* VB = (bf16*)(ws + WS_V); bf16* GT = (bf16*)args.out;
    if (RECOMP & 1) { EpiStore e{UB, D, 1.0f}; ngemm(lds, HB, D, Win, 1, D, M, D, D, e, vcu, G); }
    if (RECOMP & 6) { EpiVG e{VB, GT, args.in[4]}; ngemm(lds, HB, D, Win + (size_t)3072 * D, 1, D, M, 3072, D, e, vcu, G); }
}
#endif
constexpr int N_PHASES = 18;
extern "C" void kernel_launch(void* const* d_in, const int* in_sizes, int n_in, void* d_out, int out_size, void* d_ws, size_t ws_size, hipStream_t stream) {
    static int grid = 0;
    if (grid == 0) {
        if (n_in != 34 || in_sizes[0] != M * D || out_size != M * D || ws_size < WS_END) { fprintf(stderr, "kernel_launch: unexpected shapes (n_in %d, in0 %d, out %d, ws %zu)\n", n_in, n_in > 0 ? in_sizes[0] : -1, out_size, ws_size); grid = -1; return; }
        int dev = 0, cus = 0, per_cu = 0;
        if (hipGetDevice(&dev) != hipSuccess || hipDeviceGetAttribute(&cus, hipDeviceAttributeMultiprocessorCount, dev) != hipSuccess) { grid = -1; return; }
        if (hipFuncSetAttribute((const void*)mk_fwd, hipFuncAttributeMaxDynamicSharedMemorySize, LDS_BYTES) != hipSuccess) { fprintf(stderr, "kernel_launch: hipFuncSetAttribute failed\n"); grid = -1; return; }
        if (hipOccupancyMaxActiveBlocksPerMultiprocessor(&per_cu, (const void*)mk_fwd, NWAVES * 64, LDS_BYTES) != hipSuccess || per_cu < 1) { fprintf(stderr, "kernel_launch: occupancy query says %d\n", per_cu); per_cu = 1; }
        (void)hipGetLastError();
        grid = cus;
    }
    if (grid < 0) return;
    if (hipMemsetAsync((char*)d_ws + WS_CTL, 0, CTL_ZERO_BYTES, stream) != hipSuccess) return;
    Args a{};
    for (int i = 0; i < 34; ++i) a.in[i] = (const float*)d_in[i];
    a.out = (float*)d_out; a.ws = (unsigned char*)d_ws;
    if (MK_N_LAUNCHES == 1) { a.ph_lo = 0; a.ph_hi = N_PHASES; a.li = 0; hipLaunchKernelGGL(mk_fwd, dim3(grid), dim3(NWAVES * 64), LDS_BYTES, stream, a); }
    else { for (int p = 0; p < N_PHASES; ++p) { a.ph_lo = p; a.ph_hi = p + 1; a.li = p; hipLaunchKernelGGL(mk_fwd, dim3(grid), dim3(NWAVES * 64), LDS_BYTES, stream, a);
#ifdef RECOMP
        if (p == 1) { (void)hipFuncSetAttribute((const void*)recomp_kernel, hipFuncAttributeMaxDynamicSharedMemorySize, LDS_BYTES); hipLaunchKernelGGL(recomp_kernel, dim3(grid), dim3(NWAVES * 64), LDS_BYTES, stream, a); }
#endif
    } }
}
```

```cpp
#include <hip/hip_runtime.h>
#include <cstdio>
#include <cstdint>

#ifndef MK_N_LAUNCHES
#define MK_N_LAUNCHES 1
#endif

#ifndef FAST_MASK
#define FAST_MASK 0x1FFF
#endif
#define FAST(k) ((FAST_MASK >> (k)) & 1)
#ifndef REP_PHASE
#define REP_PHASE (-1)
#define REP_N 1
#endif
#define GAS __attribute__((address_space(1)))
#define LAS __attribute__((address_space(3)))
typedef unsigned short bf16;
typedef unsigned v4u __attribute__((ext_vector_type(4)));
typedef unsigned v2u __attribute__((ext_vector_type(2)));
typedef float f32x4 __attribute__((ext_vector_type(4)));
typedef GAS unsigned gu32;
#define RLX_AGENT __ATOMIC_RELAXED, __HIP_MEMORY_SCOPE_AGENT
#define LDS_WAIT() asm volatile("s_waitcnt lgkmcnt(0)" ::: "memory")
#define VM_WAIT() asm volatile("s_waitcnt vmcnt(0)" ::: "memory")

constexpr int BATCH = 2, SEQ = 8192, D = 1024, M = BATCH * SEQ, INC = 6144, FF = 4096, MEML = 256, MM = BATCH * MEML;
constexpr int SG = 64, SH = 16, SP = 64;
constexpr int CH = 64, NCH = SEQ / CH;
constexpr float EPS = 1e-6f;
constexpr float LOG2E = 1.4426950408889634f;
constexpr float QSCALE = 0.125f * LOG2E;
constexpr float XSCALE = 0.0625f * LOG2E;
constexpr float LAM_INIT = 0.2f;

constexpr size_t MiB = 1u << 20;
constexpr size_t WS_CTL = 0, CTL_ZERO_BYTES = 64 * 1024;
constexpr size_t WS_SCAL = 64 * 1024;
constexpr size_t WS_SSMP = 128 * 1024;
constexpr size_t WS_BF = 6 * MiB, WS_CF = 6 * MiB + 512 * 1024, WS_DF = 7 * MiB, WS_L256 = 7 * MiB + 64 * 1024;
constexpr size_t WS_COS = 1 * MiB, WS_SIN = 2 * MiB;
constexpr size_t WS_MEMN = 3 * MiB;
constexpr size_t WS_KVM = 4 * MiB;
constexpr size_t WS_WIN = 8 * MiB;
constexpr size_t WS_WGLU = 20 * MiB, WS_WSSM = 22 * MiB, WS_WDA = 24 * MiB, WS_WMIX = 26 * MiB, WS_WXQ = 28 * MiB, WS_WXO = 30 * MiB;
constexpr size_t WS_WXKV = 32 * MiB;
constexpr size_t WS_WF1 = 36 * MiB;
constexpr size_t WS_WF2 = 44 * MiB;
constexpr size_t WS_H = 52 * MiB, WS_U = 84 * MiB, WS_Q = 116 * MiB, WS_K = 148 * MiB, WS_V = 180 * MiB;
constexpr size_t WS_E = 212 * MiB, WS_SIN_C = 220 * MiB;
constexpr size_t WS_END = 228 * MiB;
constexpr int CW_BAR = 1024;

constexpr int RING_BYTES = 131072, LDS_BYTES = 147456, LDSCTL_OFF = LDS_BYTES - 1024, MISC_OFF = LDSCTL_OFF + 320;
constexpr int NWAVES = 8;

__device__ __forceinline__ unsigned f2bf(float f) { unsigned u = __builtin_bit_cast(unsigned, f); return (u + 0x7fffu + ((u >> 16) & 1u)) >> 16; }
__device__ __forceinline__ unsigned pk2(float lo, float hi) { return f2bf(lo) | (f2bf(hi) << 16); }
__device__ __forceinline__ float bf2f(unsigned short h) { return __builtin_bit_cast(float, (unsigned)h << 16); }
__device__ __forceinline__ float bflo(unsigned w) { return __builtin_bit_cast(float, w << 16); }
__device__ __forceinline__ float bfhi(unsigned w) { return __builtin_bit_cast(float, w & 0xffff0000u); }

#define XB_TMO      128
#define XB_XCNT(j)  (256  + 64 * (j))
#define XB_XSUB(j)  (1280 + 64 * (j))
#define XB_XGEN(j)  (2304 + 64 * (j))
#define XB_TOP      3328
#define XB_TOPGEN   3392
#define XCD_BAR_WORDS 3456
#define XB_SPIN_CAP (1u << 18)
__device__ __forceinline__ unsigned xb_ld(unsigned* p)              { return __hip_atomic_load(p, __ATOMIC_RELAXED, __HIP_MEMORY_SCOPE_AGENT); }
__device__ __forceinline__ unsigned xb_add(unsigned* p, unsigned v) { return __hip_atomic_fetch_add(p, v, __ATOMIC_RELAXED, __HIP_MEMORY_SCOPE_AGENT); }
__device__ __forceinline__ unsigned xb_xcc_id() { return (unsigned)__builtin_amdgcn_s_getreg((3 << 11) | 20) & 0xFu; }
#define XB_SPIN(cond, bar) do { unsigned _sp = 0; while (cond) { __builtin_amdgcn_s_sleep(1); \
    if ((++_sp & 255u) == 0u) { if (xb_ld(&(bar)[XB_TMO])) break; if (_sp > XB_SPIN_CAP) { atomicAdd(&(bar)[XB_TMO], 1u); break; } } } } while (0)
struct XcdBarrier { unsigned* bar; unsigned x; volatile LAS unsigned* st; };
__device__ __forceinline__ XcdBarrier xcd_barrier_post(unsigned* bar, volatile LAS unsigned* st) {
    XcdBarrier b; b.bar = bar; b.x = xb_xcc_id(); b.st = st;
    if (threadIdx.x == 0) (void)xb_add(&bar[XB_XCNT(b.x)], 1u);
    return b;
}
__device__ __forceinline__ void xcd_barrier_complete(unsigned* bar, unsigned x, unsigned& nloc, unsigned& nx) {
    const unsigned G = gridDim.x * gridDim.y * gridDim.z;
    unsigned sum, cnt, mine, sp = 0u;
    for (;;) {
        sum = 0u; cnt = 0u; mine = 0u;
#pragma unroll
        for (unsigned j = 0; j < 16; ++j) { const unsigned c = xb_ld(&bar[XB_XCNT(j)]); sum += c; cnt += (c > 0u) ? 1u : 0u; mine = (j == x) ? c : mine; }
        if (sum == G) break;
        __builtin_amdgcn_s_sleep(1);
        if ((++sp & 255u) == 0u) { if (xb_ld(&bar[XB_TMO])) break; if (sp > XB_SPIN_CAP) { atomicAdd(&bar[XB_TMO], 1u); break; } }
    }
    nloc = mine > 0u ? mine : 1u; nx = cnt > 0u ? cnt : 1u;
}
__device__ __forceinline__ void xcd_barrier(const XcdBarrier& b) {
    asm volatile("s_waitcnt vmcnt(0)" ::: "memory");
    __syncthreads();
    if (threadIdx.x == 0) {
        unsigned* bar = b.bar;
        __builtin_amdgcn_s_waitcnt(0);
        unsigned nloc = b.st[0], nx = b.st[1];
        if (nloc == 0u) { xcd_barrier_complete(bar, b.x, nloc, nx); b.st[0] = nloc; b.st[1] = nx; }
        const unsigned old = xb_add(&bar[XB_XSUB(b.x)], 1u);
        const unsigned gen = old / nloc;
        if (old + 1u == (gen + 1u) * nloc) {
            __builtin_amdgcn_fence(__ATOMIC_RELEASE, "agent");
            asm volatile("s_waitcnt vmcnt(0)" ::: "memory");
            const unsigned og = xb_add(&bar[XB_TOP], 1u);
            const unsigned tg = og / nx;
            if (og + 1u == (tg + 1u) * nx) xb_add(&bar[XB_TOPGEN], 1u);
            else XB_SPIN(xb_ld(&bar[XB_TOPGEN]) == tg, bar);
            __builtin_amdgcn_fence(__ATOMIC_ACQUIRE, "agent");
            xb_add(&bar[XB_XGEN(b.x)], 1u);
            asm volatile("s_waitcnt vmcnt(0)" ::: "memory");
        } else {
            XB_SPIN(xb_ld(&bar[XB_XGEN(b.x)]) == gen, bar);
            __builtin_amdgcn_fence(__ATOMIC_ACQUIRE, "agent");
            asm volatile("s_waitcnt vmcnt(0)" ::: "memory");
        }
    }
    __syncthreads();
}

struct Frame {
    LAS unsigned char* lds;
    int tid, lane, wave, vcu, G;
    const float* const* in;
};
struct Args { const float* in[34]; float* out; unsigned char* ws; int ph_lo, ph_hi, li, pad; };

__device__ __forceinline__ float wave_sum(float v) {
#pragma unroll
    for (int o = 1; o < 64; o <<= 1) v += __shfl_xor(v, o);
    return v;
}

__device__ __forceinline__ int rope_dest(int col) { const int s = col & 127, a = s >> 6, n = (s >> 5) & 1, b = (s >> 4) & 1, rest = s & 15; return (col & ~127) + 64 * a + 32 * b + 8 * (rest >> 2) + 4 * n + (rest & 3); }
template <bool ROPEPERM>
__device__ __forceinline__ void p0_transpose_item(const float* W, int K, int N, bf16* WT, LAS float* scr, int item, int lane) {
    const int nblk = N / 32, kb = item / nblk, nb = item % nblk, k0 = 64 * kb, n0 = 32 * nb;
#pragma unroll 8
    for (int i = 0; i < 32; ++i) { const int kk = 2 * i + (lane >> 5); scr[kk * 33 + (lane & 31)] = W[(size_t)(k0 + kk) * N + n0 + (lane & 31)]; }
    LDS_WAIT(); asm volatile("" ::: "memory");
    const int c = lane & 7;
#pragma unroll
    for (int j = 0; j < 4; ++j) { const int n = (lane >> 3) + 8 * j; const LAS float* s = scr + (8 * c) * 33 + n;
        v4u o; o.x = pk2(s[0 * 33], s[1 * 33]); o.y = pk2(s[2 * 33], s[3 * 33]); o.z = pk2(s[4 * 33], s[5 * 33]); o.w = pk2(s[6 * 33], s[7 * 33]);
        const int drow = (ROPEPERM && (n0 + n) >= 1024 && (n0 + n) < 3072) ? rope_dest(n0 + n) : (n0 + n);
        *(GAS v4u*)(WT + (size_t)drow * K + k0 + 8 * c) = o; }
    LDS_WAIT(); asm volatile("" ::: "memory");
}
__device__ __forceinline__ void rms_row_to_bf16(const float* xrow, const float* g, bf16* orow, int lane) {
    const GAS f32x4* xr = (const GAS f32x4*)xrow + lane; const GAS f32x4* gr = (const GAS f32x4*)g + lane;
    f32x4 v[4]; float s = 0.f;
#pragma unroll
    for (int j = 0; j < 4; ++j) { v[j] = xr[64 * j]; s += (v[j].x * v[j].x + v[j].y * v[j].y) + (v[j].z * v[j].z + v[j].w * v[j].w); }
    const float rs = 1.0f / sqrtf(wave_sum(s) * (1.f / D) + EPS);
    GAS v2u* o8 = (GAS v2u*)orow + lane;
#pragma unroll
    for (int j = 0; j < 4; ++j) { const f32x4 gg = gr[64 * j]; v2u w; w.x = pk2(v[j].x * rs * gg.x, v[j].y * rs * gg.y); w.y = pk2(v[j].z * rs * gg.z, v[j].w * rs * gg.w); o8[64 * j] = w; }
}
__device__ __forceinline__ void resnorm_row(const bf16* yrow, const float* xi, const float* g1, float* xo, const float* g2, bf16* hn, int lane) {
    const GAS v2u* yr = (const GAS v2u*)yrow + lane; const GAS f32x4* xr = (const GAS f32x4*)xi + lane; const GAS f32x4* g1r = (const GAS f32x4*)g1 + lane;
    f32x4 y[4], x[4]; float s = 0.f;
#pragma unroll
    for (int j = 0; j < 4; ++j) { const v2u w = yr[64 * j]; y[j] = (f32x4){bflo(w.x), bfhi(w.x), bflo(w.y), bfhi(w.y)}; x[j] = xr[64 * j];
        s += (y[j].x * y[j].x + y[j].y * y[j].y) + (y[j].z * y[j].z + y[j].w * y[j].w); }
    const float rs = 1.0f / sqrtf(wave_sum(s) * (1.f / D) + EPS);
    float s2 = 0.f;
#pragma unroll
    for (int j = 0; j < 4; ++j) { const f32x4 gg = g1r[64 * j]; x[j] = x[j] + y[j] * rs * gg; s2 += (x[j].x * x[j].x + x[j].y * x[j].y) + (x[j].z * x[j].z + x[j].w * x[j].w); }
    GAS f32x4* xw = (GAS f32x4*)xo + lane;
#pragma unroll
    for (int j = 0; j < 4; ++j) xw[64 * j] = x[j];
    if (hn) {
        const float rs2 = 1.0f / sqrtf(wave_sum(s2) * (1.f / D) + EPS);
        const GAS f32x4* g2r = (const GAS f32x4*)g2 + lane; GAS v2u* o8 = (GAS v2u*)hn + lane;
#pragma unroll
        for (int j = 0; j < 4; ++j) { const f32x4 gg = g2r[64 * j]; v2u w; w.x = pk2(x[j].x * rs2 * gg.x, x[j].y * rs2 * gg.y); w.y = pk2(x[j].z * rs2 * gg.z, x[j].w * rs2 * gg.w); o8[64 * j] = w; }
    }
}

__device__ __forceinline__ double rope_inv(int i) {
    const double r = 0.74989420933245582730218427561514;
    double v = 1.0;
    for (int k = 0; k < i; ++k) v *= r;
    return v;
}
__device__ __forceinline__ void sincos_reduced(double ang, float& c, float& s) {
    const double inv2pi = 0.15915494309189533576888376337251;
    const double twopi = 6.283185307179586476925286766559;
    const double k = __builtin_rint(ang * inv2pi);
    const float r = (float)(ang - k * twopi);
    c = cosf(r); s = sinf(r);
}

namespace pg8 {
#define PG8_LAS __attribute__((address_space(3)))
typedef unsigned short bf16_t;
typedef short bf16x8 __attribute__((ext_vector_type(8)));
typedef float f32x4 __attribute__((ext_vector_type(4)));
typedef unsigned u32x4 __attribute__((ext_vector_type(4)));
constexpr int BM = 256, BK = 64, HALF = 128, HTB = HALF * BK * 2  , STAGE_BYTES = 8 * HTB, NXCD = 8, WGM = 8;

__host__ __device__ __forceinline__ int lds_byte(int r, int c) { const int st = (r >> 4) * 2 + (c >> 5), rr = r & 15, cc = c & 31, ob = rr * 64 + cc * 2; return st * 1024 + (ob ^ (((ob >> 9) & 1) << 5)); }
__host__ __device__ __forceinline__ void stage_rc(int b, int& R, int& C) { const int st = b / 1024, sb = b % 1024, swz = sb ^ (((sb >> 9) & 1) << 5); R = (st >> 1) * 16 + swz / 64; C = (st & 1) * 32 + (swz % 64) / 2; }
__host__ __device__ __forceinline__ int perm32(int rho) { const int n = rho >> 4, i = rho & 15; return 8 * (i >> 2) + 4 * n + (i & 3); }

struct Unit { int pm, pn; };
struct Gemm { const bf16_t* A; const bf16_t* Bt; int M, N, K; };

struct StaticOrder {
    int nM, nN, nwg, G, c;
    __host__ __device__ void init(int M, int N, int G_, int c_) { nM = M / BM; nN = N / BM; nwg = nM * nN; G = G_; c = c_; }
    __host__ __device__ bool next(int i, Unit& u) const {
        const long L = (long)i * G + c; if (L >= nwg) return false;
        int wgid = (int)L; { const int q = nwg / NXCD, r = nwg % NXCD, xcd = wgid % NXCD, off = wgid / NXCD; wgid = (xcd < r ? xcd * (q + 1) : r * (q + 1) + (xcd - r) * q) + off; }
        const int nig = WGM * nN, gid = wgid / nig, fm = gid * WGM, gsz = (nM - fm) < WGM ? (nM - fm) : WGM;
        u.pm = fm + ((wgid % nig) % gsz); u.pn = (wgid % nig) / gsz; return true;
    }
    __device__ __forceinline__ void a_ready(const Unit&) const {}
    __device__ __forceinline__ void done(const Unit&) const {}
};


typedef float cvt_f32x2 __attribute__((ext_vector_type(2))); typedef __bf16 cvt_bf16x2 __attribute__((ext_vector_type(2)));
__device__ __forceinline__ unsigned cvt_pk_bf16(float lo, float hi) { cvt_f32x2 v = {lo, hi}; cvt_bf16x2 b = __builtin_convertvector(v, cvt_bf16x2); return __builtin_bit_cast(unsigned, b); }
typedef unsigned u32x2 __attribute__((ext_vector_type(2)));
__device__ __forceinline__ float fsigmoid(float v) { return __builtin_amdgcn_rcpf(1.0f + __builtin_amdgcn_exp2f(-1.4426950408889634f * v)); }
__device__ __forceinline__ f32x4 sig4(f32x4 v) { return (f32x4){fsigmoid(v[0]), fsigmoid(v[1]), fsigmoid(v[2]), fsigmoid(v[3])}; }
__device__ __forceinline__ f32x4 bf4(unsigned lo, unsigned hi) { return (f32x4){__builtin_bit_cast(float, lo << 16), __builtin_bit_cast(float, lo & 0xffff0000u), __builtin_bit_cast(float, hi << 16), __builtin_bit_cast(float, hi & 0xffff0000u)}; }

template <int ACT  > struct EpiBf16 {
    static constexpr bool PERM = true, AFTER_DRAIN = false;
    bf16_t* O; int ldc; float scale;
    __device__ __forceinline__ void operator()(const f32x4 (&acc)[2][2][4][2], const Unit& u, int wr, int wc, int fr, int fq) const {
        const int row0 = u.pm * BM + wr * 64 + fr, col0 = u.pn * BM + wc * 32 + 8 * fq;
#pragma unroll
        for (int ai = 0; ai < 2; ++ai)
#pragma unroll
            for (int m = 0; m < 4; ++m) { bf16_t* rowp = O + (size_t)(row0 + ai * HALF + m * 16) * ldc + col0;
#pragma unroll
                for (int bj = 0; bj < 2; ++bj) { f32x4 v0 = acc[ai][bj][m][0], v1 = acc[ai][bj][m][1];
                    if (ACT == 2) { v0 = __builtin_elementwise_max(v0, (f32x4){0.f, 0.f, 0.f, 0.f}); v1 = __builtin_elementwise_max(v1, (f32x4){0.f, 0.f, 0.f, 0.f}); v0 = v0 * v0; v1 = v1 * v1; }
                    else { v0 = v0 * scale; v1 = v1 * scale; }
                    u32x4 w; w.x = cvt_pk_bf16(v0[0], v0[1]); w.y = cvt_pk_bf16(v0[2], v0[3]); w.z = cvt_pk_bf16(v1[0], v1[1]); w.w = cvt_pk_bf16(v1[2], v1[3]);
                    *(u32x4*)(rowp + bj * HALF) = w; } }
    }
};
struct EpiInProjF {
    static constexpr bool PERM = true, AFTER_DRAIN = false;
    bf16_t *U, *Q, *K, *V, *Gt; const float *cosT, *sinT, *bgate; float qscale;
    __device__ __forceinline__ void operator()(const f32x4 (&acc)[2][2][4][2], const Unit& u, int wr, int wc, int fr, int fq) const {
        const int row0 = u.pm * BM + wr * 64 + fr, pn = u.pn;
        if (pn >= 4 && pn < 12) {
            bf16_t* dst = (pn < 8) ? Q : K; const float sc = (pn < 8) ? qscale : 1.0f;
            const int i0 = 16 * (wc & 1) + 4 * fq, cbase = (pn & 3) * 256 + 64 * (wc >> 1) + i0;
#pragma unroll
            for (int ai = 0; ai < 2; ++ai)
#pragma unroll
                for (int m = 0; m < 4; ++m) { const int row = row0 + ai * HALF + m * 16, pos = row & 8191;
                    const f32x4 cs = *(const f32x4*)(cosT + pos * 32 + i0) * sc, sn = *(const f32x4*)(sinT + pos * 32 + i0) * sc;
                    bf16_t* rowp = dst + (size_t)row * 1024 + cbase;
#pragma unroll
                    for (int bj = 0; bj < 2; ++bj) { const f32x4 t1 = acc[ai][bj][m][0], t2 = acc[ai][bj][m][1];
                        const f32x4 o1 = t1 * cs - t2 * sn, o2 = t2 * cs + t1 * sn;
                        u32x2 w1, w2; w1.x = cvt_pk_bf16(o1[0], o1[1]); w1.y = cvt_pk_bf16(o1[2], o1[3]); w2.x = cvt_pk_bf16(o2[0], o2[1]); w2.y = cvt_pk_bf16(o2[2], o2[3]);
                        *(u32x2*)(rowp + bj * HALF) = w1; *(u32x2*)(rowp + bj * HALF + 32) = w2; } }
        } else if (pn >= 16) {
            const int col0 = (pn - 16) * 256 + wc * 32 + 8 * fq;
            f32x4 bv[2][2];
#pragma unroll
            for (int bj = 0; bj < 2; ++bj)
#pragma unroll
                for (int n = 0; n < 2; ++n) bv[bj][n] = *(const f32x4*)(bgate + col0 + bj * HALF + 4 * n);
#pragma unroll
            for (int ai = 0; ai < 2; ++ai)
#pragma unroll
                for (int m = 0; m < 4; ++m) { bf16_t* rowp = Gt + (size_t)(row0 + ai * HALF + m * 16) * 2048 + col0;
#pragma unroll
                    for (int bj = 0; bj < 2; ++bj) { const f32x4 v0 = sig4(acc[ai][bj][m][0] + bv[bj][0]), v1 = sig4(acc[ai][bj][m][1] + bv[bj][1]);
                        u32x4 w; w.x = cvt_pk_bf16(v0[0], v0[1]); w.y = cvt_pk_bf16(v0[2], v0[3]); w.z = cvt_pk_bf16(v1[0], v1[1]); w.w = cvt_pk_bf16(v1[2], v1[3]);
                        *(u32x4*)(rowp + bj * HALF) = w; } }
        } else {
            bf16_t* dst = (pn < 4) ? U : V; const int col0 = (pn & 3) * 256 + wc * 32 + 8 * fq;
#pragma unroll
            for (int ai = 0; ai < 2; ++ai)
#pragma unroll
                for (int m = 0; m < 4; ++m) { bf16_t* rowp = dst + (size_t)(row0 + ai * HALF + m * 16) * 1024 + col0;
#pragma unroll
                    for (int bj = 0; bj < 2; ++bj) { const f32x4 v0 = acc[ai][bj][m][0], v1 = acc[ai][bj][m][1];
                        u32x4 w; w.x = cvt_pk_bf16(v0[0], v0[1]); w.y = cvt_pk_bf16(v0[2], v0[3]); w.z = cvt_pk_bf16(v1[0], v1[1]); w.w = cvt_pk_bf16(v1[2], v1[3]);
                        *(u32x4*)(rowp + bj * HALF) = w; } }
        }
    }
};
struct EpiGluF {
    static constexpr bool PERM = true, AFTER_DRAIN = false;
    const bf16_t* YS; bf16_t* O; const float* bglu;
    __device__ __forceinline__ void operator()(const f32x4 (&acc)[2][2][4][2], const Unit& u, int wr, int wc, int fr, int fq) const {
        const int row0 = u.pm * BM + wr * 64 + fr, col0 = u.pn * BM + wc * 32 + 8 * fq;
        f32x4 bv[2][2];
#pragma unroll
        for (int bj = 0; bj < 2; ++bj)
#pragma unroll
            for (int n = 0; n < 2; ++n) bv[bj][n] = *(const f32x4*)(bglu + col0 + bj * HALF + 4 * n);
#pragma unroll
        for (int ai = 0; ai < 2; ++ai)
#pragma unroll
            for (int m = 0; m < 4; ++m) { const size_t off = (size_t)(row0 + ai * HALF + m * 16) * 1024 + col0;
#pragma unroll
                for (int bj = 0; bj < 2; ++bj) { const u32x4 yw = *(const u32x4*)(YS + off + bj * HALF);
                    const f32x4 v0 = bf4(yw.x, yw.y) * sig4(acc[ai][bj][m][0] + bv[bj][0]), v1 = bf4(yw.z, yw.w) * sig4(acc[ai][bj][m][1] + bv[bj][1]);
                    u32x4 w; w.x = cvt_pk_bf16(v0[0], v0[1]); w.y = cvt_pk_bf16(v0[2], v0[3]); w.z = cvt_pk_bf16(v1[0], v1[1]); w.w = cvt_pk_bf16(v1[2], v1[3]);
                    *(u32x4*)(O + off + bj * HALF) = w; } }
    }
};
struct EpiMergeAF {
    static constexpr bool PERM = true, AFTER_DRAIN = false;
    const bf16_t* Gt; float* TMP;
    __device__ __forceinline__ void operator()(const f32x4 (&acc)[2][2][4][2], const Unit& u, int wr, int wc, int fr, int fq) const {
        const int row0 = u.pm * BM + wr * 64 + fr, col0 = u.pn * BM + wc * 32 + 8 * fq;
#pragma unroll
        for (int ai = 0; ai < 2; ++ai)
#pragma unroll
            for (int m = 0; m < 4; ++m) { const size_t row = (size_t)(row0 + ai * HALF + m * 16);
#pragma unroll
                for (int bj = 0; bj < 2; ++bj) { const u32x4 gw = *(const u32x4*)(Gt + row * 2048 + col0 + bj * HALF);
                    float* tp = TMP + row * 1024 + col0 + bj * HALF;
                    *(f32x4*)tp = bf4(gw.x, gw.y) * acc[ai][bj][m][0]; *(f32x4*)(tp + 4) = bf4(gw.z, gw.w) * acc[ai][bj][m][1]; } }
    }
};
struct EpiMergeBF {
    static constexpr bool PERM = true, AFTER_DRAIN = false;
    const bf16_t* Gt; const float* TMP; bf16_t* O;
    __device__ __forceinline__ void operator()(const f32x4 (&acc)[2][2][4][2], const Unit& u, int wr, int wc, int fr, int fq) const {
        const int row0 = u.pm * BM + wr * 64 + fr, col0 = u.pn * BM + wc * 32 + 8 * fq;
#pragma unroll
        for (int ai = 0; ai < 2; ++ai)
#pragma unroll
            for (int m = 0; m < 4; ++m) { const size_t row = (size_t)(row0 + ai * HALF + m * 16);
#pragma unroll
                for (int bj = 0; bj < 2; ++bj) { const u32x4 gw = *(const u32x4*)(Gt + row * 2048 + 1024 + col0 + bj * HALF);
                    const float* tp = TMP + row * 1024 + col0 + bj * HALF;
                    const f32x4 v0 = *(const f32x4*)tp + bf4(gw.x, gw.y) * acc[ai][bj][m][0], v1 = *(const f32x4*)(tp + 4) + bf4(gw.z, gw.w) * acc[ai][bj][m][1];
                    u32x4 w; w.x = cvt_pk_bf16(v0[0], v0[1]); w.y = cvt_pk_bf16(v0[2], v0[3]); w.z = cvt_pk_bf16(v1[0], v1[1]); w.w = cvt_pk_bf16(v1[2], v1[3]);
                    *(u32x4*)(O + row * 1024 + col0 + bj * HALF) = w; } }
    }
};
template <class Epi, class Sched, bool ALIGN_EPI = false, bool SP2 = false>
__device__ __forceinline__ void gemm_phase(PG8_LAS unsigned char* lds, const Gemm g, const Sched& S, const Epi& E) {
    const int tid = threadIdx.x, wid = __builtin_amdgcn_readfirstlane(tid >> 6), lane = tid & 63, wr = wid >> 2, wc = wid & 3, fr = lane & 15, fq = lane >> 4;
    const int K = g.K, nt = K / BK;
    unsigned voffA[2], voffB[2];
#pragma unroll
    for (int i = 0; i < 2; ++i) { int R, C; stage_rc(tid * 16 + i * 8192, R, C); const int Rb = Epi::PERM ? ((R & ~31) + perm32(R & 31)) : R;
        voffA[i] = (unsigned)(R * K + C) * 2u; voffB[i] = (unsigned)(Rb * K + C) * 2u; }
    const size_t kstep = (size_t)(BK * 2);
    const size_t hstep = (size_t)HALF * K * 2;
    const size_t tstep = 2 * hstep;
    const unsigned ldsw = (unsigned)wid * 1024u;
    const int aoff = lds_byte(wr * 64 + fr, fq * 8), boff = lds_byte(wc * 32 + fr, fq * 8);
#define PG8_SA(b, h) (((b) * 2 + (h)) * HTB)
#define PG8_SB(b, h) ((4 + (b) * 2 + (h)) * HTB)
#define PG8_STAGE(bufoff, gbase, voff) do { _Pragma("unroll") for (int _i = 0; _i < 2; ++_i) \
        __builtin_amdgcn_global_load_lds((const unsigned*)((const char*)(gbase) + (voff)[_i]), (PG8_LAS unsigned*)(lds + (bufoff) + ldsw + _i * 8192), 16, 0, 0); } while (0)
#define PG8_LDA(dst, b, h) do { _Pragma("unroll") for (int m = 0; m < 4; ++m) _Pragma("unroll") for (int k = 0; k < 2; ++k) dst[m][k] = *(const PG8_LAS bf16x8*)(lds + PG8_SA(b, h) + aoff + m * 2048 + k * 1024); } while (0)
#define PG8_LDB(dst, b, h) do { _Pragma("unroll") for (int n = 0; n < 2; ++n) _Pragma("unroll") for (int k = 0; k < 2; ++k) dst[n][k] = *(const PG8_LAS bf16x8*)(lds + PG8_SB(b, h) + boff + n * 2048 + k * 1024); } while (0)
#define PG8_MMA(ai, bj, At, Bt) do { __builtin_amdgcn_s_setprio(1); _Pragma("unroll") for (int m = 0; m < 4; ++m) _Pragma("unroll") for (int n = 0; n < 2; ++n) _Pragma("unroll") for (int k = 0; k < 2; ++k) \
        acc[ai][bj][m][n] = __builtin_amdgcn_mfma_f32_16x16x32_bf16(Bt[n][k], At[m][k], acc[ai][bj][m][n], 0, 0, 0); __builtin_amdgcn_s_setprio(0); } while (0)
#define PG8_WAIT_V(n) asm volatile("s_waitcnt vmcnt(" #n ")" ::: "memory")
#define PG8_WAIT_L(n) asm volatile("s_waitcnt lgkmcnt(" #n ")" ::: "memory")
#define PG8_BAR __builtin_amdgcn_s_barrier()
#define PG8_SCHED __builtin_amdgcn_sched_barrier(0)
    Unit cur, nxt; int ui = 0;
    if (!S.next(0, cur)) return;
    f32x4 acc[2][2][4][2];
#pragma unroll
    for (int a = 0; a < 2; ++a)
#pragma unroll
        for (int b = 0; b < 2; ++b)
#pragma unroll
            for (int m = 0; m < 4; ++m)
#pragma unroll
                for (int n = 0; n < 2; ++n) acc[a][b][m][n] = (f32x4){0.f, 0.f, 0.f, 0.f};
    bf16x8 At[4][2], B0[2][2], B1[2][2];
    const char* cA = (const char*)g.A + (size_t)cur.pm * tstep; const char* cB = (const char*)g.Bt + (size_t)cur.pn * tstep;
    S.a_ready(cur);
    if constexpr (SP2) {
        PG8_STAGE(PG8_SB(0, 0), cB, voffB); PG8_STAGE(PG8_SB(0, 1), cB + hstep, voffB); PG8_STAGE(PG8_SA(0, 0), cA, voffA); PG8_STAGE(PG8_SA(0, 1), cA + hstep, voffA);
        if (wr == 1) PG8_BAR;
        PG8_WAIT_V(2); PG8_BAR;
        PG8_STAGE(PG8_SB(1, 0), cB + kstep, voffB); PG8_STAGE(PG8_SA(1, 0), cA + kstep, voffA); PG8_STAGE(PG8_SB(1, 1), cB + hstep + kstep, voffB);
        PG8_WAIT_V(6); PG8_BAR;
    } else {
        PG8_STAGE(PG8_SB(0, 0), cB, voffB); PG8_STAGE(PG8_SA(0, 0), cA, voffA); PG8_STAGE(PG8_SB(0, 1), cB + hstep, voffB); PG8_STAGE(PG8_SA(0, 1), cA + hstep, voffA);
        if (wr == 1) PG8_BAR;
        PG8_WAIT_V(4); PG8_BAR;
        PG8_STAGE(PG8_SB(1, 0), cB + kstep, voffB); PG8_STAGE(PG8_SA(1, 0), cA + kstep, voffA); PG8_STAGE(PG8_SB(1, 1), cB + hstep + kstep, voffB);
        PG8_WAIT_V(6); PG8_BAR;
    }
    for (;;) {
        const bool has_next = S.next(ui + 1, nxt);
        const char* nA = has_next ? (const char*)g.A + (size_t)nxt.pm * tstep : cA; const char* nB = has_next ? (const char*)g.Bt + (size_t)nxt.pn * tstep : cB;
        for (int t = 0; t < nt; t += 2) {
            const bool last = (t == nt - 2);
            const char* a1 = cA + (size_t)(t + 1) * kstep;
            const char* a2 = last ? nA : cA + (size_t)(t + 2) * kstep; const char* b2 = last ? nB : cB + (size_t)(t + 2) * kstep;
            const char* a3 = a2 + kstep; const char* b3 = b2 + kstep;
            if (last && has_next) S.a_ready(nxt);
            if constexpr (SP2) {
            PG8_LDB(B0, 0, 0); PG8_LDB(B1, 0, 1); PG8_SCHED; PG8_LDA(At, 0, 0); PG8_STAGE(PG8_SA(1, 1), a1 + hstep, voffA);
            PG8_WAIT_V(8); PG8_WAIT_L(0); PG8_BAR; PG8_MMA(0, 0, At, B0); PG8_MMA(0, 1, At, B1); PG8_BAR; PG8_SCHED;
            PG8_LDA(At, 0, 1); PG8_STAGE(PG8_SB(0, 0), b2, voffB); PG8_STAGE(PG8_SB(0, 1), b2 + hstep, voffB); PG8_STAGE(PG8_SA(0, 0), a2, voffA);
            PG8_WAIT_V(8); PG8_WAIT_L(0); PG8_BAR; PG8_MMA(1, 0, At, B0); PG8_MMA(1, 1, At, B1); PG8_BAR; PG8_SCHED;
            PG8_LDB(B0, 1, 0); PG8_LDB(B1, 1, 1); PG8_SCHED; PG8_LDA(At, 1, 0); PG8_STAGE(PG8_SA(0, 1), a2 + hstep, voffA);
            PG8_WAIT_V(8); PG8_WAIT_L(0); PG8_BAR; PG8_MMA(0, 0, At, B0); PG8_MMA(0, 1, At, B1); PG8_BAR; PG8_SCHED;
            PG8_LDA(At, 1, 1); PG8_STAGE(PG8_SB(1, 0), b3, voffB); PG8_STAGE(PG8_SB(1, 1), b3 + hstep, voffB); PG8_STAGE(PG8_SA(1, 0), a3, voffA);
            PG8_WAIT_V(8); PG8_WAIT_L(0); PG8_BAR; PG8_MMA(1, 0, At, B0); PG8_MMA(1, 1, At, B1); PG8_BAR; PG8_SCHED;
            } else {
            PG8_LDB(B0, 0, 0); PG8_SCHED; PG8_LDA(At, 0, 0); PG8_STAGE(PG8_SA(1, 1), a1 + hstep, voffA);
            PG8_WAIT_L(8); PG8_BAR; PG8_WAIT_L(0); PG8_MMA(0, 0, At, B0); PG8_BAR; PG8_SCHED;
            PG8_LDB(B1, 0, 1); PG8_STAGE(PG8_SB(0, 0), b2, voffB);
            PG8_BAR; PG8_WAIT_L(0); PG8_MMA(0, 1, At, B1); PG8_BAR;
            PG8_LDA(At, 0, 1); PG8_STAGE(PG8_SA(0, 0), a2, voffA);
            PG8_BAR; PG8_WAIT_L(0); PG8_MMA(1, 0, At, B0); PG8_BAR; PG8_SCHED;
            PG8_STAGE(PG8_SB(0, 1), b2 + hstep, voffB);
            PG8_WAIT_V(6); PG8_BAR; PG8_MMA(1, 1, At, B1); PG8_BAR;
            PG8_LDB(B0, 1, 0); PG8_SCHED; PG8_LDA(At, 1, 0); PG8_STAGE(PG8_SA(0, 1), a2 + hstep, voffA);
            PG8_WAIT_L(8); PG8_BAR; PG8_WAIT_L(0); PG8_MMA(0, 0, At, B0); PG8_BAR; PG8_SCHED;
            PG8_LDB(B1, 1, 1); PG8_STAGE(PG8_SB(1, 0), b3, voffB);
            PG8_BAR; PG8_WAIT_L(0); PG8_MMA(0, 1, At, B1); PG8_BAR;
            PG8_LDA(At, 1, 1); PG8_STAGE(PG8_SA(1, 0), a3, voffA);
            PG8_BAR; PG8_WAIT_L(0); PG8_MMA(1, 0, At, B0); PG8_BAR; PG8_SCHED;
            PG8_STAGE(PG8_SB(1, 1), b3 + hstep, voffB);
            PG8_WAIT_V(6); PG8_BAR; PG8_MMA(1, 1, At, B1); PG8_BAR;
            }
        }
        if constexpr (ALIGN_EPI) { if (wr == 0) PG8_BAR; }
        if constexpr (!Epi::AFTER_DRAIN) { E(acc, cur, wr, wc, fr, fq); S.done(cur); }
        if (!has_next) break;
#pragma unroll
        for (int a = 0; a < 2; ++a)
#pragma unroll
            for (int b = 0; b < 2; ++b)
#pragma unroll
                for (int m = 0; m < 4; ++m)
#pragma unroll
                    for (int n = 0; n < 2; ++n) acc[a][b][m][n] = (f32x4){0.f, 0.f, 0.f, 0.f};
        cur = nxt; cA = nA; cB = nB; ++ui;
        if constexpr (ALIGN_EPI) { if (wr == 1) PG8_BAR; }
    }
    PG8_WAIT_V(0);
    if constexpr (!ALIGN_EPI) { if (wr == 0) PG8_BAR; }
    PG8_BAR;
    if constexpr (Epi::AFTER_DRAIN) { E.fused(acc, cur, wr, wc, fr, fq, lds, wid, lane); S.done(cur); }
#undef PG8_SA
#undef PG8_SB
#undef PG8_STAGE
#undef PG8_LDA
#undef PG8_LDB
#undef PG8_MMA
#undef PG8_WAIT_V
#undef PG8_WAIT_L
#undef PG8_BAR
#undef PG8_SCHED
}
}


namespace att {
typedef short bf16x8 __attribute__((ext_vector_type(8)));
typedef short s16x4 __attribute__((ext_vector_type(4)));
typedef float f32x16 __attribute__((ext_vector_type(16)));
typedef unsigned u32x4 __attribute__((ext_vector_type(4)));
typedef LAS const char* lds_cptr;
constexpr int NSLOT = 3, KSLOT = 8192, VSLOT = 16384;
constexpr int LDS_K = 0, LDS_V = NSLOT * KSLOT, LDS_WS = LDS_V + NSLOT * VSLOT, LDS_OST = LDS_WS + 8 * 256, LDS_END = LDS_OST + 8 * 8192;
constexpr float THR = 8.0f;
__device__ __forceinline__ int crow(int r, int hi) { return (r & 3) + 8 * (r >> 2) + 4 * hi; }
__device__ __forceinline__ void glds16(const void* gsrc, unsigned lds_dst) { unsigned keep;
    asm volatile("s_mov_b32 %0, m0\n\ts_mov_b32 m0, %2\n\ts_nop 0\n\tglobal_load_lds_dwordx4 %1, off\n\ts_mov_b32 m0, %0" : "=&s"(keep) : "v"(gsrc), "s"(lds_dst) : "memory"); }
__device__ __forceinline__ s16x4 vtr(lds_cptr p) { typedef short v4i16_t __attribute__((ext_vector_type(4))); return __builtin_bit_cast(s16x4, __builtin_amdgcn_ds_read_tr16_b64_v4i16((LAS v4i16_t*)p)); }
__device__ __forceinline__ unsigned cvtpk(float lo, float hi) { typedef float f2 __attribute__((ext_vector_type(2))); typedef __bf16 b2 __attribute__((ext_vector_type(2))); f2 v = {lo, hi}; b2 b = __builtin_convertvector(v, b2); return __builtin_bit_cast(unsigned, b); }
__device__ __forceinline__ float swapmax(float m) { auto rr = __builtin_amdgcn_permlane32_swap(__float_as_uint(m), __float_as_uint(m), false, false); return fmaxf(__uint_as_float(rr[0]), __uint_as_float(rr[1])); }
__device__ __forceinline__ float swapadd(float m) { auto rr = __builtin_amdgcn_permlane32_swap(__float_as_uint(m), __float_as_uint(m), false, false); return __uint_as_float(rr[0]) + __uint_as_float(rr[1]); }
#define ATT_WAIT_BAR(N) asm volatile("s_waitcnt vmcnt(" #N ") lgkmcnt(0)\n\ts_barrier" ::: "memory")

__device__ __forceinline__ void attn_unit(int b, int h, int qb, bf16* QO, const bf16* __restrict__ Kb, const bf16* __restrict__ Vb, LAS unsigned char* lds, float lam, const float* head_norm) {
    const int tid = threadIdx.x, lane = tid & 63, r32 = lane & 31, hi = lane >> 5; const int wid = __builtin_amdgcn_readfirstlane(tid >> 6);
    const long rowbase = (long)b * SEQ; const int q0 = qb * 256;
    const int NT = 4 * qb + 4, tmax = 4 * qb + (wid >> 1);
    const unsigned lds0 = (unsigned)(uintptr_t)lds;
    LAS float* wsf = (LAS float*)(lds + LDS_WS) + wid * 64;
    LAS unsigned short* stash = (LAS unsigned short*)(lds + LDS_OST + wid * 8192);
    const bf16* Vh = Vb + rowbase * D + h * 128;
    const bf16* vsrc1 = Vh + (long)(16 * (wid & 3) + (lane >> 2)) * D + (wid >> 2) * 32 + (lane & 3) * 8;
    const bf16* vsrc2 = vsrc1 + 64;
    const unsigned kdst = lds0 + LDS_K + wid * 1024, vdst1 = lds0 + LDS_V + wid * 1024, vdst2 = vdst1 + 8192;
    const lds_cptr kp0 = (lds_cptr)lds + LDS_K + hi * 1024 + r32 * 16;
    const lds_cptr vp0 = (lds_cptr)lds + LDS_V + ((lane >> 4) & 1) * 32 + (lane & 3) * 8 + (4 * hi + ((lane & 15) >> 2)) * 64;
#pragma unroll 1
    for (int c = 0; c < 2; ++c) {
        const bf16* ksrc = Kb + (rowbase + lane) * D + h * 128 + c * 64 + wid * 8;
#define ATT_DMA(t, slot) do { glds16(ksrc + (long)(t) * 64 * D, (unsigned)__builtin_amdgcn_readfirstlane(kdst + (slot) * KSLOT)); \
        glds16(vsrc1 + (long)(t) * 64 * D, (unsigned)__builtin_amdgcn_readfirstlane(vdst1 + (slot) * VSLOT)); glds16(vsrc2 + (long)(t) * 64 * D, (unsigned)__builtin_amdgcn_readfirstlane(vdst2 + (slot) * VSLOT)); } while (0)
        bf16x8 qr[4];
        { const bf16* Qw = QO + (rowbase + q0 + wid * 32 + r32) * D + h * 128 + c * 64 + hi * 8;
#pragma unroll
          for (int s = 0; s < 4; ++s) qr[s] = *(const bf16x8*)(Qw + s * 16); }
        ATT_DMA(0, 0); ATT_DMA(1, 1);
        float mhat = 0.f, l_reg = 0.f; f32x16 o[4]; f32x16 negm;
#pragma unroll
        for (int r = 0; r < 16; ++r) { negm[r] = 0.f; o[0][r] = 0.f; o[1][r] = 0.f; o[2][r] = 0.f; o[3][r] = 0.f; }
        int slot = 0;
#pragma unroll 1
        for (int t = 0; t < NT; ++t) {
            if (t + 1 < NT) ATT_WAIT_BAR(3); else ATT_WAIT_BAR(0);
            if (t + 2 < NT) { const int s2 = (slot >= 1) ? slot - 1 : 2; ATT_DMA(t + 2, s2); }
            if (t <= tmax) {
                f32x16 p0, p1;
                { const lds_cptr kb = kp0 + slot * KSLOT;
#pragma unroll
                  for (int s = 0; s < 4; ++s) { const bf16x8 b0 = *(const LAS bf16x8*)(kb + s * 2048), b1 = *(const LAS bf16x8*)(kb + s * 2048 + 512);
                      if (s == 0) { p0 = __builtin_amdgcn_mfma_f32_32x32x16_bf16(b0, qr[0], negm, 0, 0, 0); p1 = __builtin_amdgcn_mfma_f32_32x32x16_bf16(b1, qr[0], negm, 0, 0, 0); }
                      else { p0 = __builtin_amdgcn_mfma_f32_32x32x16_bf16(b0, qr[s], p0, 0, 0, 0); p1 = __builtin_amdgcn_mfma_f32_32x32x16_bf16(b1, qr[s], p1, 0, 0, 0); } } }
                asm volatile("s_nop 15\n\ts_nop 7" : "+v"(p0), "+v"(p1));
                float rm = fmaxf(p0[0], p1[0]);
#pragma unroll
                for (int r = 1; r < 16; ++r) rm = fmaxf(rm, fmaxf(p0[r], p1[r]));
                rm = swapmax(rm);
                if (t == 0 || __any(rm > THR)) {
                    const float dl = (t == 0) ? rm : fmaxf(rm, 0.f); mhat += dl;
#pragma unroll
                    for (int r = 0; r < 16; ++r) { p0[r] -= dl; p1[r] -= dl; negm[r] = -mhat; }
                    if (t != 0) { const float f = __builtin_amdgcn_exp2f(-dl); l_reg *= f; if (hi == 0) wsf[r32] = f;
                        asm volatile("s_waitcnt lgkmcnt(0)" ::: "memory");
#pragma unroll
                        for (int r = 0; r < 16; ++r) { const float fr = wsf[crow(r, hi)]; o[0][r] *= fr; o[1][r] *= fr; o[2][r] *= fr; o[3][r] *= fr; }
                        asm volatile("s_waitcnt lgkmcnt(0)" ::: "memory"); }
                }
                float sacc = 0.f;
#pragma unroll
                for (int r = 0; r < 16; ++r) { p0[r] = __builtin_amdgcn_exp2f(p0[r]); p1[r] = __builtin_amdgcn_exp2f(p1[r]); sacc += p0[r] + p1[r]; }
                l_reg += sacc;
                u32x4 pw[4];
#pragma unroll
                for (int k = 0; k < 2; ++k) { pw[k] = (u32x4){cvtpk(p0[8 * k], p0[8 * k + 1]), cvtpk(p0[8 * k + 2], p0[8 * k + 3]), cvtpk(p0[8 * k + 4], p0[8 * k + 5]), cvtpk(p0[8 * k + 6], p0[8 * k + 7])};
                    pw[2 + k] = (u32x4){cvtpk(p1[8 * k], p1[8 * k + 1]), cvtpk(p1[8 * k + 2], p1[8 * k + 3]), cvtpk(p1[8 * k + 4], p1[8 * k + 5]), cvtpk(p1[8 * k + 6], p1[8 * k + 7])}; }
                { const lds_cptr vp = vp0 + slot * VSLOT;
#pragma unroll
                  for (int db = 0; db < 4; ++db)
#pragma unroll
                      for (int ks = 0; ks < 4; ++ks) { const s16x4 lo = vtr(vp + db * 4096 + ks * 1024), hh = vtr(vp + db * 4096 + ks * 1024 + 512);
                          const bf16x8 vf = (bf16x8){lo[0], lo[1], lo[2], lo[3], hh[0], hh[1], hh[2], hh[3]};
                          o[db] = __builtin_amdgcn_mfma_f32_32x32x16_bf16(__builtin_bit_cast(bf16x8, pw[ks]), vf, o[db], 0, 0, 0); } }
            }
            slot = (slot == 2) ? 0 : slot + 1;
        }
        asm volatile("s_waitcnt lgkmcnt(0)\n\ts_barrier" ::: "memory");
        asm volatile("s_nop 15\n\ts_nop 15" : "+v"(o[0]), "+v"(o[1]), "+v"(o[2]), "+v"(o[3]));
        const float ltot = swapadd(l_reg);
        if (hi == 0) wsf[32 + r32] = 1.0f / ltot;
        asm volatile("s_waitcnt lgkmcnt(0)" ::: "memory");
        float rli[16];
#pragma unroll
        for (int r = 0; r < 16; ++r) rli[r] = wsf[32 + crow(r, hi)];
        asm volatile("s_waitcnt lgkmcnt(0)" ::: "memory");
        if (c == 0) {
#pragma unroll
            for (int r = 0; r < 16; ++r) { const int orow = crow(r, hi);
#pragma unroll
                for (int db = 0; db < 4; ++db) stash[orow * 128 + db * 32 + r32] = (unsigned short)f2bf(o[db][r] * rli[r]); }
            asm volatile("s_waitcnt lgkmcnt(0)" ::: "memory");
        } else {
            float ss[16];
#pragma unroll
            for (int r = 0; r < 16; ++r) { const int orow = crow(r, hi); float a = 0.f;
#pragma unroll
                for (int db = 0; db < 4; ++db) { const float v = bf2f(stash[orow * 128 + db * 32 + r32]) - lam * (o[db][r] * rli[r]); o[db][r] = v; a += v * v; }
                ss[r] = a; }
#pragma unroll
            for (int r = 0; r < 16; ++r) { float a = ss[r]; a += __shfl_xor(a, 1); a += __shfl_xor(a, 2); a += __shfl_xor(a, 4); a += __shfl_xor(a, 8); a += __shfl_xor(a, 16);
                ss[r] = (1.0f - LAM_INIT) / sqrtf(a * (1.0f / 128.0f) + EPS); }
            float hn[4];
#pragma unroll
            for (int db = 0; db < 4; ++db) hn[db] = head_norm[db * 32 + r32];
            asm volatile("s_waitcnt lgkmcnt(0)" ::: "memory");
#pragma unroll
            for (int r = 0; r < 16; ++r) { const int orow = crow(r, hi);
#pragma unroll
                for (int db = 0; db < 4; ++db) stash[orow * 128 + db * 32 + r32] = (unsigned short)f2bf(o[db][r] * ss[r] * hn[db]); }
            asm volatile("s_waitcnt lgkmcnt(0)" ::: "memory");
            bf16* Ow = QO + (rowbase + q0 + wid * 32) * D + h * 128;
#pragma unroll
            for (int i = 0; i < 8; ++i) { const int row = i * 4 + (lane >> 4), ch = lane & 15; const u32x4 v = *(const LAS u32x4*)(stash + row * 128 + ch * 8); *(u32x4*)(Ow + (long)row * D + ch * 8) = v; }
            asm volatile("s_waitcnt lgkmcnt(0)" ::: "memory");
        }
#undef ATT_DMA
    }
}

constexpr int XK = 0, XKS = 32768, XV = 65536, XVS = 16384, XWS = 98304;
__device__ __forceinline__ void xattn_unit(int b, int hd, int qb, const bf16* __restrict__ Qx, const bf16* __restrict__ KV, bf16* __restrict__ O, LAS unsigned char* lds) {
    const int tid = threadIdx.x, lane = tid & 63, r32 = lane & 31, hi = lane >> 5; const int wid = __builtin_amdgcn_readfirstlane(tid >> 6);
    const unsigned lds0 = (unsigned)(uintptr_t)lds;
    LAS float* wsf = (LAS float*)(lds + XWS) + wid * 64;
    LAS unsigned short* stash = (LAS unsigned short*)(lds + wid * 8192);
    const long qrow0 = (long)b * SEQ + qb * 256 + wid * 32;
    const bf16* kbase = KV + (long)(b * MEML) * 2048 + hd * 256;
    const lds_cptr kp0 = (lds_cptr)lds + XK + hi * 1024 + r32 * 16;
    const lds_cptr vp0 = (lds_cptr)lds + XV + ((lane >> 4) & 1) * 32 + (lane & 3) * 8 + (4 * hi + ((lane & 15) >> 2)) * 64;
    const bf16* Qw = Qx + (qrow0 + r32) * D + hd * 256 + hi * 8;
#pragma unroll 1
    for (int dh = 0; dh < 2; ++dh) {
        const bf16* vsrc = kbase + 1024 + dh * 128 + (long)(16 * (wid & 3) + (lane >> 2)) * 2048 + (wid >> 2) * 32 + (lane & 3) * 8;
#define XDMA(t, slot) do { \
        _Pragma("unroll") for (int i_ = 0; i_ < 4; ++i_) { const int ch_ = wid + 8 * i_; \
            glds16(kbase + (long)((t) * 64 + lane) * 2048 + ch_ * 8, (unsigned)__builtin_amdgcn_readfirstlane(lds0 + XK + (slot) * XKS + ch_ * 1024)); } \
        glds16(vsrc + (long)(t) * 64 * 2048, (unsigned)__builtin_amdgcn_readfirstlane(lds0 + XV + (slot) * XVS + wid * 1024)); \
        glds16(vsrc + (long)(t) * 64 * 2048 + 64, (unsigned)__builtin_amdgcn_readfirstlane(lds0 + XV + (slot) * XVS + wid * 1024 + 8192)); } while (0)
        XDMA(0, 0); XDMA(1, 1);
        float mhat = 0.f, l_reg = 0.f; f32x16 o[4]; f32x16 negm;
#pragma unroll
        for (int r = 0; r < 16; ++r) { negm[r] = 0.f; o[0][r] = 0.f; o[1][r] = 0.f; o[2][r] = 0.f; o[3][r] = 0.f; }
#pragma unroll 1
        for (int t = 0; t < 4; ++t) {
            const int slot = t & 1;
            if (t < 3) ATT_WAIT_BAR(6); else ATT_WAIT_BAR(0);
            f32x16 p0, p1;
            { const lds_cptr kb = kp0 + slot * XKS;
              p0 = negm; p1 = negm;
#pragma unroll
              for (int sg = 0; sg < 4; ++sg) {
                  bf16x8 qf[4];
#pragma unroll
                  for (int s4 = 0; s4 < 4; ++s4) qf[s4] = *(const bf16x8*)(Qw + (sg * 4 + s4) * 16);
#pragma unroll
                  for (int s4 = 0; s4 < 4; ++s4) { const int s = sg * 4 + s4; const bf16x8 b0 = *(const LAS bf16x8*)(kb + s * 2048), b1 = *(const LAS bf16x8*)(kb + s * 2048 + 512);
                      p0 = __builtin_amdgcn_mfma_f32_32x32x16_bf16(b0, qf[s4], p0, 0, 0, 0); p1 = __builtin_amdgcn_mfma_f32_32x32x16_bf16(b1, qf[s4], p1, 0, 0, 0); }
                  __builtin_amdgcn_sched_barrier(0); } }
            asm volatile("s_nop 15\n\ts_nop 7" : "+v"(p0), "+v"(p1));
            float rm = fmaxf(p0[0], p1[0]);
#pragma unroll
            for (int r = 1; r < 16; ++r) rm = fmaxf(rm, fmaxf(p0[r], p1[r]));
            rm = swapmax(rm);
            if (t == 0 || __any(rm > THR)) {
                const float dl = (t == 0) ? rm : fmaxf(rm, 0.f); mhat += dl;
#pragma unroll
                for (int r = 0; r < 16; ++r) { p0[r] -= dl; p1[r] -= dl; negm[r] = -mhat; }
                if (t != 0) { const float f = __builtin_amdgcn_exp2f(-dl); l_reg *= f; if (hi == 0) wsf[r32] = f;
                    asm volatile("s_waitcnt lgkmcnt(0)" ::: "memory");
#pragma unroll
                    for (int r = 0; r < 16; ++r) { const float fr = wsf[crow(r, hi)]; o[0][r] *= fr; o[1][r] *= fr; o[2][r] *= fr; o[3][r] *= fr; }
                    asm volatile("s_waitcnt lgkmcnt(0)" ::: "memory"); }
            }
            float sacc = 0.f;
#pragma unroll
            for (int r = 0; r < 16; ++r) { p0[r] = __builtin_amdgcn_exp2f(p0[r]); p1[r] = __builtin_amdgcn_exp2f(p1[r]); sacc += p0[r] + p1[r]; }
            l_reg += sacc;
            u32x4 pw[4];
#pragma unroll
            for (int k = 0; k < 2; ++k) { pw[k] = (u32x4){cvtpk(p0[8 * k], p0[8 * k + 1]), cvtpk(p0[8 * k + 2], p0[8 * k + 3]), cvtpk(p0[8 * k + 4], p0[8 * k + 5]), cvtpk(p0[8 * k + 6], p0[8 * k + 7])};
                pw[2 + k] = (u32x4){cvtpk(p1[8 * k], p1[8 * k + 1]), cvtpk(p1[8 * k + 2], p1[8 * k + 3]), cvtpk(p1[8 * k + 4], p1[8 * k + 5]), cvtpk(p1[8 * k + 6], p1[8 * k + 7])}; }
            { const lds_cptr vp = vp0 + slot * XVS;
#pragma unroll
              for (int db = 0; db < 4; ++db)
#pragma unroll
                  for (int ks = 0; ks < 4; ++ks) { const s16x4 lo = vtr(vp + db * 4096 + ks * 1024), hh = vtr(vp + db * 4096 + ks * 1024 + 512);
                      const bf16x8 vf = (bf16x8){lo[0], lo[1], lo[2], lo[3], hh[0], hh[1], hh[2], hh[3]};
                      o[db] = __builtin_amdgcn_mfma_f32_32x32x16_bf16(__builtin_bit_cast(bf16x8, pw[ks]), vf, o[db], 0, 0, 0); } }
            asm volatile("s_waitcnt lgkmcnt(0)\n\ts_barrier" ::: "memory");
            if (t + 2 < 4) XDMA(t + 2, slot);
        }
        asm volatile("s_nop 15\n\ts_nop 15" : "+v"(o[0]), "+v"(o[1]), "+v"(o[2]), "+v"(o[3]));
        const float ltot = swapadd(l_reg);
        if (hi == 0) wsf[32 + r32] = 1.0f / ltot;
        asm volatile("s_waitcnt lgkmcnt(0)" ::: "memory");
#pragma unroll
        for (int r = 0; r < 16; ++r) { const int orow = crow(r, hi); const float rl = wsf[32 + orow];
#pragma unroll
            for (int db = 0; db < 4; ++db) stash[orow * 128 + db * 32 + r32] = (unsigned short)f2bf(o[db][r] * rl); }
        asm volatile("s_waitcnt lgkmcnt(0)" ::: "memory");
        bf16* Ow = O + qrow0 * D + hd * 256 + dh * 128;
#pragma unroll
        for (int i = 0; i < 8; ++i) { const int row = i * 4 + (lane >> 4), ch = lane & 15; const u32x4 v = *(const LAS u32x4*)(stash + row * 128 + ch * 8); *(u32x4*)(Ow + (long)row * D + ch * 8) = v; }
        asm volatile("s_waitcnt lgkmcnt(0)\n\ts_barrier" ::: "memory");
#undef XDMA
    }
}
}
constexpr int NG_LD = 132, NG_TLD = 129;
template <class Epi>
__device__ __forceinline__ void ngemm(LAS unsigned char* lds, const bf16* A, int lda, const bf16* B, int sbk, int sbn, int Mr, int Nc, int Kd, const Epi& epi, int vcu, int G) {
    LAS float* As = (LAS float*)lds; LAS float* Bs = As + 16 * NG_LD; LAS float* T = Bs + 16 * NG_LD;
    const int tid = threadIdx.x, ty = tid >> 4, tx = tid & 15;
    const int nTn = Nc / 128, nT = (Mr / 128) * nTn;
    for (int tile = vcu; tile < nT; tile += G) {
        const int tm = tile / nTn, tn = tile % nTn;
        float acc[4][8];
#pragma unroll
        for (int i = 0; i < 4; ++i)
#pragma unroll
            for (int j = 0; j < 8; ++j) acc[i][j] = 0.f;
        const int lr = tid >> 2, lk = (tid & 3) * 4;
        for (int k0 = 0; k0 < Kd; k0 += 16) {
            { const bf16* ap = A + (size_t)(tm * 128 + lr) * lda + k0 + lk;
#pragma unroll
              for (int j = 0; j < 4; ++j) As[(lk + j) * NG_LD + lr] = bf2f(ap[j]); }
            { const bf16* bp = B + (size_t)(k0 + lk) * sbk + (size_t)(tn * 128 + lr) * sbn;
#pragma unroll
              for (int j = 0; j < 4; ++j) Bs[(lk + j) * NG_LD + lr] = bf2f(bp[(size_t)j * sbk]); }
            __syncthreads();
#pragma unroll
            for (int kk = 0; kk < 16; ++kk) {
                const f32x4 a = *(const LAS f32x4*)(As + kk * NG_LD + ty * 4);
                const f32x4 b0 = *(const LAS f32x4*)(Bs + kk * NG_LD + tx * 8), b1 = *(const LAS f32x4*)(Bs + kk * NG_LD + tx * 8 + 4);
#pragma unroll
                for (int i = 0; i < 4; ++i) {
#pragma unroll
                    for (int j = 0; j < 4; ++j) { acc[i][j] += a[i] * b0[j]; acc[i][4 + j] += a[i] * b1[j]; }
                }
            }
            __syncthreads();
        }
#pragma unroll
        for (int i = 0; i < 4; ++i)
#pragma unroll
            for (int j = 0; j < 8; ++j) T[(ty * 4 + i) * NG_TLD + tx * 8 + j] = acc[i][j];
        __syncthreads();
        for (int idx = tid; idx < 128 * 128; idx += 512) { const int r = idx >> 7, c = idx & 127; epi(tm * 128 + r, tn * 128 + c, T, r, c); }
        __syncthreads();
    }
}
__device__ __forceinline__ float sigmoidf_(float v) { return 1.0f / (1.0f + __expf(-v)); }
__device__ __forceinline__ float gelu_tanh(float x) { const float u = 0.7978845608028654f * (x + 0.044715f * x * x * x); return x / (1.0f + __expf(-2.0f * u)); }


namespace ssm {
typedef short bf16x8 __attribute__((ext_vector_type(8)));
typedef float f32x16 __attribute__((ext_vector_type(16)));
constexpr int CHK = 256, NCK = SEQ / CHK, IMG_LD = 136;
constexpr int IMG_BYTES = 32 * IMG_LD * 2;
template <bool FULL>
__device__ __forceinline__ void ssm_wave(int b, int g, int cp, const bf16* __restrict__ U, bf16* __restrict__ YS, float* __restrict__ E, const float* __restrict__ SINC,
                                         const bf16* __restrict__ BF, const bf16* __restrict__ CF, const bf16* __restrict__ DF, const float* __restrict__ lamb, LAS unsigned short* img, int lane) {
    const int s = lane & 31, hi = lane >> 5;
    const int hr = (s >> 2) & 1, jrow = 4 * (s >> 3) + (s & 3);
    const bf16* aptr = U + ((size_t)b * SEQ + (size_t)(2 * cp + hr) * CHK + jrow) * D + g * SH + 8 * hi;
    bf16x8 bfr[4][2];
#pragma unroll
    for (int cb = 0; cb < 4; ++cb)
#pragma unroll
        for (int pt = 0; pt < 2; ++pt) bfr[cb][pt] = *(const bf16x8*)(BF + ((size_t)((g * 4 + cb) * 2 + pt) * 64 + lane) * 8);
    const float l0r = lamb[(g * SP + s) * 4 + 0], l0i = lamb[(g * SP + s) * 4 + 1], l1r = lamb[(g * SP + s + 32) * 4 + 0], l1i = lamb[(g * SP + s + 32) * 4 + 1];
    float x0r = 0.f, x0i = 0.f, x1r = 0.f, x1i = 0.f;
    const size_t eoff = (((size_t)(b * SG + g) * NCK + (2 * cp + hi)) * SP + s) * 2;
    if (FULL) { x0r = SINC[eoff]; x0i = SINC[eoff + 1]; x1r = SINC[eoff + 64]; x1i = SINC[eoff + 65]; }
    bf16x8 cfr[8]; bf16x8 dfr;
    if (FULL) {
#pragma unroll
        for (int ks = 0; ks < 8; ++ks) cfr[ks] = *(const bf16x8*)(CF + ((size_t)(g * 8 + ks) * 64 + lane) * 8);
        dfr = *(const bf16x8*)(DF + ((size_t)g * 64 + lane) * 8);
    }
    bf16x8 afr = *(const bf16x8*)aptr;
#pragma unroll 1
    for (int blk = 0; blk < CHK / 16; ++blk) {
        const bf16x8 acur = afr;
        if (blk + 1 < CHK / 16) afr = *(const bf16x8*)(aptr + (size_t)(blk + 1) * 16 * D);
        f32x16 acc[4];
#pragma unroll
        for (int cb = 0; cb < 4; ++cb) {
#pragma unroll
            for (int r = 0; r < 16; ++r) acc[cb][r] = 0.f;
            acc[cb] = __builtin_amdgcn_mfma_f32_32x32x16_bf16(acur, bfr[cb][0], acc[cb], 0, 0, 0);
            acc[cb] = __builtin_amdgcn_mfma_f32_32x32x16_bf16(acur, bfr[cb][1], acc[cb], 0, 0, 0);
        }
        asm volatile("s_nop 15\n\ts_nop 15" : "+v"(acc[0]), "+v"(acc[1]), "+v"(acc[2]), "+v"(acc[3]));
#pragma unroll
        for (int r = 0; r < 16; ++r) {
            const float n0r = l0r * x0r - l0i * x0i + acc[0][r], n0i = l0r * x0i + l0i * x0r + acc[2][r]; x0r = n0r; x0i = n0i; acc[0][r] = n0r; acc[2][r] = n0i;
            const float n1r = l1r * x1r - l1i * x1i + acc[1][r], n1i = l1r * x1i + l1i * x1r + acc[3][r]; x1r = n1r; x1i = n1i; acc[1][r] = n1r; acc[3][r] = n1i;
        }
        if (FULL) {
#pragma unroll
            for (int r = 0; r < 16; ++r) { const int row = (r & 3) + 8 * (r >> 2) + 4 * hi;
#pragma unroll
                for (int cb = 0; cb < 4; ++cb) img[row * IMG_LD + 32 * cb + s] = (unsigned short)f2bf(acc[cb][r]); }
            asm volatile("s_waitcnt lgkmcnt(0)" ::: "memory");
            f32x16 y, y2;
#pragma unroll
            for (int r = 0; r < 16; ++r) { y[r] = 0.f; y2[r] = 0.f; }
#pragma unroll
            for (int ks = 0; ks < 8; ks += 2) { const bf16x8 xa = *(const LAS bf16x8*)(img + s * IMG_LD + 16 * ks + 8 * hi), xb = *(const LAS bf16x8*)(img + s * IMG_LD + 16 * (ks + 1) + 8 * hi);
                y = __builtin_amdgcn_mfma_f32_32x32x16_bf16(xa, cfr[ks], y, 0, 0, 0); y2 = __builtin_amdgcn_mfma_f32_32x32x16_bf16(xb, cfr[ks + 1], y2, 0, 0, 0); }
            y = __builtin_amdgcn_mfma_f32_32x32x16_bf16(acur, dfr, y, 0, 0, 0);
            asm volatile("s_nop 15\n\ts_nop 15\n\ts_nop 15" : "+v"(y), "+v"(y2));
#pragma unroll
            for (int r = 0; r < 16; ++r) y[r] += y2[r];
            bf16* yp = YS + ((size_t)b * SEQ + (size_t)(2 * cp + hi) * CHK + blk * 16) * D + g * SH + (s & 15);
#pragma unroll
            for (int r = 0; r < 16; ++r) { const float v = y[r] + __shfl_xor(y[r], 16); if (s < 16) yp[(size_t)r * D] = (bf16)f2bf(gelu_tanh(v)); }
            asm volatile("s_waitcnt lgkmcnt(0)" ::: "memory");
        }
    }
    if (!FULL) { E[eoff] = x0r; E[eoff + 1] = x0i; E[eoff + 64] = x1r; E[eoff + 65] = x1i; }
}
}
struct EpiStore { bf16* O; int ld; float scale;
    __device__ __forceinline__ void operator()(int row, int col, const LAS float* T, int r, int c) const { O[(size_t)row * ld + col] = (bf16)f2bf(T[r * NG_TLD + c] * scale); } };
struct EpiStoreF32 { float* O; int ld;
    __device__ __forceinline__ void operator()(int row, int col, const LAS float* T, int r, int c) const { O[(size_t)row * ld + col] = T[r * NG_TLD + c]; } };
struct EpiInProj { bf16 *U, *Q, *K, *V, *Gt; const float *cosT, *sinT, *bgate;
    __device__ __forceinline__ void operator()(int row, int col, const LAS float* T, int r, int c) const {
        const float v = T[r * NG_TLD + c];
        if (col < 1024) { U[(size_t)row * D + col] = (bf16)f2bf(v); return; }
        if (col < 3072) { const int cc = (col - 1024) & 1023, d = cc & 63, i = d & 31, pos = row & (SEQ - 1);
            const float cs = cosT[pos * 32 + i], sn = sinT[pos * 32 + i];
            const float o = (d < 32) ? (v * cs - T[r * NG_TLD + c + 32] * sn) : (v * cs + T[r * NG_TLD + c - 32] * sn);
            if (col < 2048) Q[(size_t)row * D + cc] = (bf16)f2bf(o * QSCALE); else K[(size_t)row * D + cc] = (bf16)f2bf(o);
            return; }
        if (col < 4096) { V[(size_t)row * D + (col - 3072)] = (bf16)f2bf(v); return; }
        Gt[(size_t)row * 2048 + (col - 4096)] = (bf16)f2bf(sigmoidf_(v + bgate[col - 4096]));
    } };
struct EpiGlu { const bf16* YS; bf16* O; const float* bglu;
    __device__ __forceinline__ void operator()(int row, int col, const LAS float* T, int r, int c) const {
        const float t = T[r * NG_TLD + c] + bglu[col]; const float ys = bf2f(YS[(size_t)row * D + col]);
        O[(size_t)row * D + col] = (bf16)f2bf(ys * sigmoidf_(t)); } };
struct EpiMergeA { const bf16* Gt; float* TMP;
    __device__ __forceinline__ void operator()(int row, int col, const LAS float* T, int r, int c) const {
        TMP[(size_t)row * D + col] = bf2f(Gt[(size_t)row * 2048 + col]) * T[r * NG_TLD + c]; } };
struct EpiMergeB { const bf16* Gt; const float* TMP; bf16* O;
    __device__ __forceinline__ void operator()(int row, int col, const LAS float* T, int r, int c) const {
        O[(size_t)row * D + col] = (bf16)f2bf(TMP[(size_t)row * D + col] + bf2f(Gt[(size_t)row * 2048 + 1024 + col]) * T[r * NG_TLD + c]); } };
struct EpiGateN { bf16* Gt; const float* bgate;
    __device__ __forceinline__ void operator()(int row, int col, const LAS float* T, int r, int c) const { Gt[(size_t)row * 2048 + col] = (bf16)f2bf(sigmoidf_(T[r * NG_TLD + c] + bgate[col])); } };
struct EpiRelu2 { bf16* O; int ld;
    __device__ __forceinline__ void operator()(int row, int col, const LAS float* T, int r, int c) const { const float v = fmaxf(T[r * NG_TLD + c], 0.f); O[(size_t)row * ld + col] = (bf16)f2bf(v * v); } };

typedef const __attribute__((address_space(4))) Args* KArgP;
__device__ __forceinline__ KArgP late_args() { KArgP p = (KArgP)__builtin_amdgcn_kernarg_segment_ptr(); asm volatile("" : "+s"(p)); return p; }
#define INP(k) ((const float*)late_args()->in[k])
__global__ void __launch_bounds__(NWAVES * 64, 2) mk_fwd(Args args) {
    extern __shared__ __attribute__((aligned(16))) unsigned char lds_raw[];
    LAS unsigned char* lds = (LAS unsigned char*)lds_raw;
    volatile LAS unsigned* MISC = (volatile LAS unsigned*)(lds + MISC_OFF);
    const int tid = threadIdx.x, lane = tid & 63, wave = __builtin_amdgcn_readfirstlane(tid >> 6);
    const int G = gridDim.x; const int bx = blockIdx.x; const int vcu = (G % 8 == 0) ? (bx % 8) * (G / 8) + bx / 8 : bx;
    unsigned char* ws = args.ws;
    gu32* ctl = (gu32*)(ws + WS_CTL);
    for (int u = tid; u < (LDS_BYTES - LDSCTL_OFF) / 4; u += NWAVES * 64) ((LAS unsigned*)(lds + LDSCTL_OFF))[u] = 0u;
    __syncthreads();
    XcdBarrier bar; bar.bar = (unsigned*)(ctl + CW_BAR); bar.x = 0; bar.st = nullptr;
    if (MK_N_LAUNCHES == 1) bar = xcd_barrier_post((unsigned*)(ctl + CW_BAR), MISC + 8);
    const int lo = args.ph_lo, hi = args.ph_hi;
#define IN(k) (lo <= (k) && (k) < hi)
#define SEAM(k) do { if (IN(k) && IN((k) + 1)) xcd_barrier(bar); } while (0)
#define REPEAT(k) for (int rep_ = 0; rep_ < (((k) == REP_PHASE) ? REP_N : 1); ++rep_, ((k) == REP_PHASE && rep_ < REP_N) ? xcd_barrier(bar) : (void)0)

    float* out = late_args()->out;
    float* scal = (float*)(ws + WS_SCAL); float* lamb = (float*)(ws + WS_SSMP); float* bbar = lamb + SG * SP * 4;
    float* cosT = (float*)(ws + WS_COS); float* sinT = (float*)(ws + WS_SIN);
    bf16* BFt = (bf16*)(ws + WS_BF); bf16* CFt = (bf16*)(ws + WS_CF); bf16* DFt = (bf16*)(ws + WS_DF); float* L256 = (float*)(ws + WS_L256);
    bf16* MEMN = (bf16*)(ws + WS_MEMN); bf16* KVM = (bf16*)(ws + WS_KVM);
    bf16* Win = (bf16*)(ws + WS_WIN); bf16* Wglu = (bf16*)(ws + WS_WGLU); bf16* Wssm = (bf16*)(ws + WS_WSSM); bf16* Wda = (bf16*)(ws + WS_WDA); bf16* Wmix = (bf16*)(ws + WS_WMIX);
    bf16* Wxq = (bf16*)(ws + WS_WXQ); bf16* Wxo = (bf16*)(ws + WS_WXO); bf16* Wxkv = (bf16*)(ws + WS_WXKV); bf16* Wf1 = (bf16*)(ws + WS_WF1); bf16* Wf2 = (bf16*)(ws + WS_WF2);
    bf16* HB = (bf16*)(ws + WS_H); bf16* UB = (bf16*)(ws + WS_U); bf16* QB = (bf16*)(ws + WS_Q); bf16* KB = (bf16*)(ws + WS_K); bf16* VB = (bf16*)(ws + WS_V);
    bf16* GT = (bf16*)out;
    float* EB = (float*)(ws + WS_E); float* SINB = (float*)(ws + WS_SIN_C);
    const int gw = vcu * NWAVES + wave, NGW = G * NWAVES;

    if (IN(0)) REPEAT(0) { const float* x = INP(0); const float* mem = INP(1); const float* g_mix_pre = INP(2); const float* w_in = INP(3); const float* lam_re = INP(5); const float* lam_im = INP(6); const float* log_dt = INP(7); const float* sb_re = INP(8); const float* sb_im = INP(9); const float* sc_re = INP(10); const float* sc_im = INP(11); const float* ssm_d = INP(12); const float* w_glu = INP(13); const float* w_ssm = INP(15); const float* lq1 = INP(16); const float* lk1 = INP(17); const float* lq2 = INP(18); const float* lk2 = INP(19); const float* w_da = INP(21); const float* w_mix = INP(22); const float* g_mem = INP(25); const float* w_xq = INP(26); const float* w_xkv = INP(27); const float* w_xo = INP(28); const float* w_ff1 = INP(31); const float* w_ff2 = INP(32);
#ifdef DELAY_TEST
        { const unsigned long long t0 = __builtin_amdgcn_s_memrealtime(); while (__builtin_amdgcn_s_memrealtime() - t0 < (unsigned long long)DELAY_TEST) __builtin_amdgcn_s_sleep(10); }
#endif
#ifdef SCRIBBLE_TEST
        for (size_t i = (size_t)bx * 512 + tid; i < (size_t)M * D / 4; i += (size_t)G * 512) ((GAS f32x4*)out)[i] = (f32x4){1.0f, 2.0f, 3.0f, 4.0f};
#endif
        LAS float* scr = (LAS float*)(lds + wave * 16384);
        constexpr int I_IN = 16 * 192, I_SQ = 16 * 32, I_KV = 16 * 64, I_F1 = 16 * 128, I_F2 = 64 * 32;
        constexpr int NITEMS = I_IN + 6 * I_SQ + I_KV + I_F1 + I_F2;
        for (int it = gw; it < NITEMS; it += NGW) {
            int r = it;
            if (r < I_IN) { p0_transpose_item<FAST(0) != 0>(w_in, D, INC, Win, scr, r, lane); continue; } r -= I_IN;
            if (r < I_SQ) { p0_transpose_item<false>(w_glu, D, D, Wglu, scr, r, lane); continue; } r -= I_SQ;
            if (r < I_SQ) { p0_transpose_item<false>(w_ssm, D, D, Wssm, scr, r, lane); continue; } r -= I_SQ;
            if (r < I_SQ) { p0_transpose_item<false>(w_da, D, D, Wda, scr, r, lane); continue; } r -= I_SQ;
            if (r < I_SQ) { p0_transpose_item<false>(w_mix, D, D, Wmix, scr, r, lane); continue; } r -= I_SQ;
            if (r < I_SQ) { p0_transpose_item<false>(w_xq, D, D, Wxq, scr, r, lane); continue; } r -= I_SQ;
            if (r < I_SQ) { p0_transpose_item<false>(w_xo, D, D, Wxo, scr, r, lane); continue; } r -= I_SQ;
            if (r < I_KV) { p0_transpose_item<false>(w_xkv, D, 2 * D, Wxkv, scr, r, lane); continue; } r -= I_KV;
            if (r < I_F1) { p0_transpose_item<false>(w_ff1, D, FF, Wf1, scr, r, lane); continue; } r -= I_F1;
            p0_transpose_item<false>(w_ff2, FF, D, Wf2, scr, r, lane);
        }
        for (int m = gw; m < M; m += NGW) rms_row_to_bf16(x + (size_t)m * D, g_mix_pre, HB + (size_t)m * D, lane);
        for (int m = gw; m < MM; m += NGW) rms_row_to_bf16(mem + (size_t)m * D, g_mem, MEMN + (size_t)m * D, lane);
        for (int idx = vcu * 512 + tid; idx < SEQ * 32; idx += G * 512) { const int pos = idx >> 5, i = idx & 31; float c, s; sincos_reduced((double)pos * rope_inv(i), c, s); cosT[idx] = c; sinT[idx] = s; }
        for (int idx = vcu * 512 + tid; idx < SG * SP; idx += G * 512) {
            const int g = idx >> 6;
            const double lr = (double)lam_re[idx], li = (double)lam_im[idx], dt = exp((double)log_dt[g]);
            const double zr = lr * dt, zi = li * dt;
            float c1, s1; sincos_reduced(zi, c1, s1);
            const double er = exp(zr), br = er * (double)c1, bi = er * (double)s1;
            float c64, s64; sincos_reduced(64.0 * zi, c64, s64);
            const double e64 = exp(64.0 * zr);
            lamb[idx * 4 + 0] = (float)br; lamb[idx * 4 + 1] = (float)bi; lamb[idx * 4 + 2] = (float)(e64 * (double)c64); lamb[idx * 4 + 3] = (float)(e64 * (double)s64);
            const double nr = br - 1.0, ni = bi, den = lr * lr + li * li;
            const double fr = (nr * lr + ni * li) / den, fi = (ni * lr - nr * li) / den;
            const int p = idx & 63, pl = p & 31, pb = p >> 5;
            for (int h = 0; h < SH; ++h) { const double b_r = (double)sb_re[idx * SH + h], b_i = (double)sb_im[idx * SH + h];
                const float vr = (float)(fr * b_r - fi * b_i), vi = (float)(fr * b_i + fi * b_r);
                bbar[idx * 32 + h] = vr; bbar[idx * 32 + 16 + h] = vi;
                const int ln = pl + 32 * (h >> 3), j = h & 7;
                const unsigned rh = f2bf(vr), ih = f2bf(vi); const unsigned rl = f2bf(vr - bf2f((unsigned short)rh)), il = f2bf(vi - bf2f((unsigned short)ih));
                BFt[((size_t)((g * 4 + pb) * 2 + 0) * 64 + ln) * 8 + j] = (bf16)rh; BFt[((size_t)((g * 4 + pb) * 2 + 1) * 64 + ln) * 8 + j] = (bf16)rl;
                BFt[((size_t)((g * 4 + 2 + pb) * 2 + 0) * 64 + ln) * 8 + j] = (bf16)ih; BFt[((size_t)((g * 4 + 2 + pb) * 2 + 1) * 64 + ln) * 8 + j] = (bf16)il; }
            for (int hp = 0; hp < SH; ++hp) { const float cre = sc_re[(size_t)(g * SH + hp) * SP + p], cim = -sc_im[(size_t)(g * SH + hp) * SP + p];
                const unsigned rh = f2bf(cre), ih = f2bf(cim); const unsigned rl = f2bf(cre - bf2f((unsigned short)rh)), il = f2bf(cim - bf2f((unsigned short)ih));
                { const int kc = p, ks = kc >> 4, half = (kc >> 3) & 1, j = kc & 7; bf16* q = CFt + ((size_t)(g * 8 + ks) * 64 + 32 * half) * 8 + j; q[(size_t)hp * 8] = (bf16)rh; q[(size_t)(16 + hp) * 8] = (bf16)rl; }
                { const int kc = 64 + p, ks = kc >> 4, half = (kc >> 3) & 1, j = kc & 7; bf16* q = CFt + ((size_t)(g * 8 + ks) * 64 + 32 * half) * 8 + j; q[(size_t)hp * 8] = (bf16)ih; q[(size_t)(16 + hp) * 8] = (bf16)il; } }
            { float c256, s256; sincos_reduced(256.0 * zi, c256, s256); const double e256 = exp(256.0 * zr); L256[idx * 2] = (float)(e256 * (double)c256); L256[idx * 2 + 1] = (float)(e256 * (double)s256); }
        }
        for (int idx = vcu * 512 + tid; idx < SG * SH; idx += G * 512) { const int g = idx >> 4, h = idx & 15; const float dv = ssm_d[idx];
            const unsigned dh = f2bf(dv), dl = f2bf(dv - bf2f((unsigned short)dh));
            for (int n = 0; n < 32; ++n) DFt[((size_t)g * 64 + n + 32 * (h >> 3)) * 8 + (h & 7)] = (bf16)(((n & 15) == h) ? ((n < 16) ? dh : dl) : 0u); }
        if (vcu == 0 && wave == 0) {
            const float a = wave_sum(lq1[lane] * lk1[lane]), b = wave_sum(lq2[lane] * lk2[lane]);
            if (lane == 0) scal[0] = expf(a) - expf(b) + LAM_INIT;
        }
    }
    SEAM(0);
    if (IN(1)) REPEAT(1) { const float* b_gate = INP(4);
#ifdef SCRIBBLE_TEST
        { unsigned bad = 0;
          for (size_t i = (size_t)bx * 512 + tid; i < (size_t)M * D / 4; i += (size_t)G * 512) { const f32x4 v = ((const GAS f32x4*)out)[i]; bad |= (v[0] != 1.0f) | (v[1] != 2.0f) | (v[2] != 3.0f) | (v[3] != 4.0f); }
          if (bad) __hip_atomic_store(ctl + 8, 1u, RLX_AGENT);
          __syncthreads(); }
#endif

#if FAST(0)
        { pg8::Gemm g{HB, Win, M, INC, D}; pg8::StaticOrder S; S.init(M, INC, G, bx);
          pg8::EpiInProjF e{UB, QB, KB, VB, GT, cosT, sinT, b_gate, QSCALE};
          pg8::gemm_phase<pg8::EpiInProjF, pg8::StaticOrder, true, true>(lds, g, S, e); }
#if FAST(9)
        { pg8::Gemm g{MEMN, Wxkv, MM, 2 * D, D}; pg8::StaticOrder S; S.init(MM, 2 * D, G, bx);
          pg8::EpiBf16<0> e{KVM, 2 * D, 1.0f};
          pg8::gemm_phase<pg8::EpiBf16<0>, pg8::StaticOrder, true, true>(lds, g, S, e); }
#else
        { EpiStore e2{KVM, 2 * D, 1.0f}; ngemm(lds, MEMN, D, Wxkv, 1, D, MM, 2 * D, D, e2, vcu, G); }
#endif
#else
        EpiInProj e{UB, QB, KB, VB, GT, cosT, sinT, b_gate};
        ngemm(lds, HB, D, Win, 1, D, M, INC, D, e, vcu, G);
        EpiStore e2{KVM, 2 * D, 1.0f};
        ngemm(lds, MEMN, D, Wxkv, 1, D, MM, 2 * D, D, e2, vcu, G);
#endif

    }
    SEAM(1);
    if (IN(2)) REPEAT(2) {
#if FAST(12)
        { const int b = vcu >> 7, cp = (vcu >> 3) & 15, g = (vcu & 7) * 8 + wave;
          ssm::ssm_wave<false>(b, g, cp, UB, nullptr, EB, nullptr, BFt, CFt, DFt, lamb, (LAS unsigned short*)nullptr, lane); }
#else

        for (int unit = gw; unit < BATCH * SG * NCH; unit += NGW) {
            const int c = unit % NCH, g = (unit / NCH) % SG, b = unit / (NCH * SG);
            const int gp = g * SP + lane;
            const float lbr = lamb[gp * 4 + 0], lbi = lamb[gp * 4 + 1];
            float br[16], bi[16];
#pragma unroll
            for (int h = 0; h < 16; ++h) { br[h] = bbar[gp * 32 + h]; bi[h] = bbar[gp * 32 + 16 + h]; }
            float xr = 0.f, xi = 0.f;
            const bf16* up = UB + (size_t)(b * SEQ + c * CH) * D + g * SH;
            for (int t = 0; t < CH; ++t) {
                const v4u w0 = *(const GAS v4u*)(up + (size_t)t * D), w1 = *(const GAS v4u*)(up + (size_t)t * D + 8);
                const float u[16] = {bflo(w0.x), bfhi(w0.x), bflo(w0.y), bfhi(w0.y), bflo(w0.z), bfhi(w0.z), bflo(w0.w), bfhi(w0.w), bflo(w1.x), bfhi(w1.x), bflo(w1.y), bfhi(w1.y), bflo(w1.z), bfhi(w1.z), bflo(w1.w), bfhi(w1.w)};
                float ar = 0.f, ai = 0.f;
#pragma unroll
                for (int h = 0; h < 16; ++h) { ar += br[h] * u[h]; ai += bi[h] * u[h]; }
                const float nr = lbr * xr - lbi * xi + ar, ni = lbr * xi + lbi * xr + ai; xr = nr; xi = ni;
            }
            float* e = EB + ((size_t)((b * SG + g) * NCH + c) * SP + lane) * 2; e[0] = xr; e[1] = xi;
        }
#endif
    }
    SEAM(2);
    if (IN(3)) REPEAT(3) {
#if FAST(12)
        for (int idx = vcu * 512 + tid; idx < BATCH * SG * SP; idx += G * 512) {
            const int p = idx & 63, g = (idx >> 6) & 63, b = idx >> 12; const int gp = g * SP + p;
            const float tr = L256[gp * 2], ti = L256[gp * 2 + 1];
            const size_t base = ((size_t)(b * SG + g) * ssm::NCK) * SP + p;
            float er[ssm::NCK], ei[ssm::NCK];
#pragma unroll
            for (int c = 0; c < ssm::NCK; ++c) { const size_t o = (base + (size_t)c * SP) * 2; er[c] = EB[o]; ei[c] = EB[o + 1]; }
            float sr = 0.f, si = 0.f;
#pragma unroll
            for (int c = 0; c < ssm::NCK; ++c) { const size_t o = (base + (size_t)c * SP) * 2; SINB[o] = sr; SINB[o + 1] = si;
                const float nr = tr * sr - ti * si + er[c], ni = tr * si + ti * sr + ei[c]; sr = nr; si = ni; }
        }
#else

        for (int idx = vcu * 512 + tid; idx < BATCH * SG * SP; idx += G * 512) {
            const int p = idx & 63, g = (idx >> 6) & 63, b = idx >> 12; const int gp = g * SP + p;
            const float tr = lamb[gp * 4 + 2], ti = lamb[gp * 4 + 3];
            float sr = 0.f, si = 0.f;
            const size_t base = ((size_t)(b * SG + g) * NCH) * SP + p;
            for (int c = 0; c < NCH; ++c) {
                const size_t o = (base + (size_t)c * SP) * 2;
                SINB[o] = sr; SINB[o + 1] = si;
                const float er = EB[o], ei = EB[o + 1];
                const float nr = tr * sr - ti * si + er, ni = tr * si + ti * sr + ei; sr = nr; si = ni;
            }
        }
#endif
    }
    SEAM(3);
    if (IN(4)) REPEAT(4) { const float* sc_re = INP(10); const float* sc_im = INP(11); const float* ssm_d = INP(12);
#if FAST(12)
        { const int b = vcu >> 7, cp = (vcu >> 3) & 15, g = (vcu & 7) * 8 + wave;
          ssm::ssm_wave<true>(b, g, cp, UB, HB, nullptr, SINB, BFt, CFt, DFt, lamb, (LAS unsigned short*)(lds + wave * ssm::IMG_BYTES), lane); }
#else
        LAS float* xs = (LAS float*)(lds + wave * 1024);
        for (int unit = gw; unit < BATCH * SG * NCH; unit += NGW) {
            const int c = unit % NCH, g = (unit / NCH) % SG, b = unit / (NCH * SG);
            const int gp = g * SP + lane;
            const float lbr = lamb[gp * 4 + 0], lbi = lamb[gp * 4 + 1];
            float br[16], bi[16], cr[16], ci[16];
#pragma unroll
            for (int h = 0; h < 16; ++h) { br[h] = bbar[gp * 32 + h]; bi[h] = bbar[gp * 32 + 16 + h]; }
            const int hh = lane & 15, pq = lane >> 4;
#pragma unroll
            for (int j = 0; j < 16; ++j) { cr[j] = sc_re[(size_t)(g * SH + hh) * SP + pq * 16 + j]; ci[j] = sc_im[(size_t)(g * SH + hh) * SP + pq * 16 + j]; }
            const float dsk = ssm_d[g * SH + hh];
            const float* sp = SINB + ((size_t)((b * SG + g) * NCH + c) * SP + lane) * 2;
            float xr = sp[0], xi = sp[1];
            const bf16* up = UB + (size_t)(b * SEQ + c * CH) * D + g * SH;
            bf16* yp = HB + (size_t)(b * SEQ + c * CH) * D + g * SH;
            for (int t = 0; t < CH; ++t) {
                const v4u w0 = *(const GAS v4u*)(up + (size_t)t * D), w1 = *(const GAS v4u*)(up + (size_t)t * D + 8);
                const float u[16] = {bflo(w0.x), bfhi(w0.x), bflo(w0.y), bfhi(w0.y), bflo(w0.z), bfhi(w0.z), bflo(w0.w), bfhi(w0.w), bflo(w1.x), bfhi(w1.x), bflo(w1.y), bfhi(w1.y), bflo(w1.z), bfhi(w1.z), bflo(w1.w), bfhi(w1.w)};
                float ar = 0.f, ai = 0.f;
#pragma unroll
                for (int h = 0; h < 16; ++h) { ar += br[h] * u[h]; ai += bi[h] * u[h]; }
                const float nr = lbr * xr - lbi * xi + ar, ni = lbr * xi + lbi * xr + ai; xr = nr; xi = ni;
                xs[lane] = xr; xs[64 + lane] = xi;
                LDS_WAIT(); asm volatile("" ::: "memory");
                float y = 0.f;
#pragma unroll
                for (int j = 0; j < 16; ++j) y += cr[j] * xs[pq * 16 + j] - ci[j] * xs[64 + pq * 16 + j];
                y += __shfl_xor(y, 16); y += __shfl_xor(y, 32);
                float uh = u[0];
#pragma unroll
                for (int h = 1; h < 16; ++h) uh = (hh == h) ? u[h] : uh;
                y += dsk * uh;
                if (lane < 16) yp[(size_t)t * D + hh] = (bf16)f2bf(gelu_tanh(y));
                LDS_WAIT(); asm volatile("" ::: "memory");
            }
        }
#endif
    }
    SEAM(4);
    if (IN(5)) REPEAT(5) { const float* head_norm = INP(20);
#if FAST(10)
        { static_assert(att::LDS_END <= LDSCTL_OFF, "attention LDS map");
          const float lam = __builtin_bit_cast(float, __hip_atomic_load((unsigned*)scal, RLX_AGENT));
          const int bh = vcu >> 4, s = vcu & 15;
          att::attn_unit(bh >> 3, bh & 7, 31 - s, QB, KB, VB, lds, lam, head_norm);
          att::attn_unit(bh >> 3, bh & 7, s, QB, KB, VB, lds, lam, head_norm); }
#else
        const float lam = scal[0];
        const int row = tid >> 3, sl = tid & 7;
        for (int i = 0; i < 8; ++i) {
            const int slot = (i & 1) ? (i * 256 + 255 - vcu) : (i * 256 + vcu);
            if (slot >= BATCH * 8 * 128) break;
            const int qc = 127 - (slot >> 4), bh = slot & 15, b = bh >> 3, h = bh & 7;
            const size_t rbase = (size_t)b * SEQ;
            const bf16* qp = QB + (rbase + qc * 64 + row) * D + h * 128;
            v4u q1p[8], q2p[8];
#pragma unroll
            for (int c8 = 0; c8 < 8; ++c8) { q1p[c8] = *(const GAS v4u*)(qp + c8 * 8); q2p[c8] = *(const GAS v4u*)(qp + 64 + c8 * 8); }
            float o1[16], o2[16]; float m1 = -1e30f, m2 = -1e30f, l1 = 0.f, l2 = 0.f;
#pragma unroll
            for (int j = 0; j < 16; ++j) { o1[j] = 0.f; o2[j] = 0.f; }
            const int nk = 64 * (qc + 1);
            for (int j = 0; j < nk; ++j) {
                const bf16* kp = KB + (rbase + j) * D + h * 128; const bf16* vp = VB + (rbase + j) * D + h * 128 + sl * 16;
                float s1 = 0.f, s2 = 0.f;
#pragma unroll
                for (int c8 = 0; c8 < 8; ++c8) { const v4u w = *(const GAS v4u*)(kp + c8 * 8); const v4u q = q1p[c8];
                    s1 += bflo(q.x) * bflo(w.x) + bfhi(q.x) * bfhi(w.x) + bflo(q.y) * bflo(w.y) + bfhi(q.y) * bfhi(w.y) + bflo(q.z) * bflo(w.z) + bfhi(q.z) * bfhi(w.z) + bflo(q.w) * bflo(w.w) + bfhi(q.w) * bfhi(w.w); }
#pragma unroll
                for (int c8 = 0; c8 < 8; ++c8) { const v4u w = *(const GAS v4u*)(kp + 64 + c8 * 8); const v4u q = q2p[c8];
                    s2 += bflo(q.x) * bflo(w.x) + bfhi(q.x) * bfhi(w.x) + bflo(q.y) * bflo(w.y) + bfhi(q.y) * bfhi(w.y) + bflo(q.z) * bflo(w.z) + bfhi(q.z) * bfhi(w.z) + bflo(q.w) * bflo(w.w) + bfhi(q.w) * bfhi(w.w); }
                const v4u v0 = *(const GAS v4u*)vp, v1 = *(const GAS v4u*)(vp + 8);
                const float vv[16] = {bflo(v0.x), bfhi(v0.x), bflo(v0.y), bfhi(v0.y), bflo(v0.z), bfhi(v0.z), bflo(v0.w), bfhi(v0.w), bflo(v1.x), bfhi(v1.x), bflo(v1.y), bfhi(v1.y), bflo(v1.z), bfhi(v1.z), bflo(v1.w), bfhi(v1.w)};
                { const float mn = fmaxf(m1, s1), a = __builtin_amdgcn_exp2f(m1 - mn), p = __builtin_amdgcn_exp2f(s1 - mn); m1 = mn; l1 = l1 * a + p;
#pragma unroll
                  for (int d = 0; d < 16; ++d) o1[d] = o1[d] * a + p * vv[d]; }
                { const float mn = fmaxf(m2, s2), a = __builtin_amdgcn_exp2f(m2 - mn), p = __builtin_amdgcn_exp2f(s2 - mn); m2 = mn; l2 = l2 * a + p;
#pragma unroll
                  for (int d = 0; d < 16; ++d) o2[d] = o2[d] * a + p * vv[d]; }
            }
            const float i1 = 1.0f / l1, i2 = lam / l2; float ss = 0.f;
#pragma unroll
            for (int d = 0; d < 16; ++d) { o1[d] = o1[d] * i1 - o2[d] * i2; ss += o1[d] * o1[d]; }
            ss += __shfl_xor(ss, 1); ss += __shfl_xor(ss, 2); ss += __shfl_xor(ss, 4);
            const float rs = (1.0f - LAM_INIT) / sqrtf(ss * (1.0f / 128.0f) + EPS);
            bf16* op = QB + (rbase + qc * 64 + row) * D + h * 128 + sl * 16;
            unsigned w[8];
#pragma unroll
            for (int d = 0; d < 8; ++d) w[d] = pk2(o1[2 * d] * rs * head_norm[sl * 16 + 2 * d], o1[2 * d + 1] * rs * head_norm[sl * 16 + 2 * d + 1]);
            *(GAS v4u*)op = (v4u){w[0], w[1], w[2], w[3]}; *(GAS v4u*)(op + 8) = (v4u){w[4], w[5], w[6], w[7]};
        }
#endif
    }
    SEAM(5);
    if (IN(6)) REPEAT(6) { const float* b_glu = INP(14);
#if FAST(1)
{ pg8::Gemm g{HB, Wglu, M, D, D}; pg8::StaticOrder S; S.init(M, D, G, bx); pg8::EpiGluF e{HB, UB, b_glu};
        pg8::gemm_phase<pg8::EpiGluF, pg8::StaticOrder, false, true>(lds, g, S, e); }
#else
{ EpiGlu e{HB, UB, b_glu}; ngemm(lds, HB, D, Wglu, 1, D, M, D, D, e, vcu, G); }
#endif
    }

    SEAM(6);
    if (IN(7)) REPEAT(7) {
#if FAST(2)
{ pg8::Gemm g{UB, Wssm, M, D, D}; pg8::StaticOrder S; S.init(M, D, G, bx); pg8::EpiMergeAF e{GT, (float*)KB};
        pg8::gemm_phase<pg8::EpiMergeAF, pg8::StaticOrder, false, true>(lds, g, S, e); }
#else
{ EpiMergeA e{GT, (float*)KB}; ngemm(lds, UB, D, Wssm, 1, D, M, D, D, e, vcu, G); }
#endif
    }

    SEAM(7);
    if (IN(8)) REPEAT(8) {
#if FAST(3)
{ pg8::Gemm g{QB, Wda, M, D, D}; pg8::StaticOrder S; S.init(M, D, G, bx); pg8::EpiMergeBF e{GT, (const float*)KB, UB};
        pg8::gemm_phase<pg8::EpiMergeBF, pg8::StaticOrder, false, true>(lds, g, S, e); }
#else
{ EpiMergeB e{GT, (const float*)KB, UB}; ngemm(lds, QB, D, Wda, 1, D, M, D, D, e, vcu, G); }
#endif
    }

    SEAM(8);
    if (IN(9)) REPEAT(9) {
#if FAST(4)
{ pg8::Gemm g{UB, Wmix, M, D, D}; pg8::StaticOrder S; S.init(M, D, G, bx); pg8::EpiBf16<0> e{QB, D, 1.0f};
        pg8::gemm_phase<pg8::EpiBf16<0>, pg8::StaticOrder, false, true>(lds, g, S, e); }
#else
{ EpiStore e{QB, D, 1.0f}; ngemm(lds, UB, D, Wmix, 1, D, M, D, D, e, vcu, G); }
#endif
    }

    SEAM(9);
    if (IN(10)) REPEAT(10) { const float* x = INP(0); const float* g_mix_post = INP(23); const float* g_x_pre = INP(24); for (int m = gw; m < M; m += NGW) resnorm_row(QB + (size_t)m * D, x + (size_t)m * D, g_mix_post, out + (size_t)m * D, g_x_pre, HB + (size_t)m * D, lane); }
    SEAM(10);
    if (IN(11)) REPEAT(11) {
#if FAST(5)
{ pg8::Gemm g{HB, Wxq, M, D, D}; pg8::StaticOrder S; S.init(M, D, G, bx); pg8::EpiBf16<0> e{UB, D, XSCALE};
        pg8::gemm_phase<pg8::EpiBf16<0>, pg8::StaticOrder, false, true>(lds, g, S, e); }
#else
{ EpiStore e{UB, D, XSCALE}; ngemm(lds, HB, D, Wxq, 1, D, M, D, D, e, vcu, G); }
#endif
    }

    SEAM(11);
    if (IN(12)) REPEAT(12) {
#if FAST(11)
        for (int unit = vcu; unit < BATCH * 4 * (SEQ / 256); unit += G) { const int qb = unit & 31, hd = (unit >> 5) & 3, b = unit >> 7; att::xattn_unit(b, hd, qb, UB, KVM, QB, lds); }
#else

        LAS float* qs = (LAS float*)lds; LAS float* Ss = qs + 32 * 256;
        for (int unit = vcu; unit < BATCH * 4 * (SEQ / 32); unit += G) {
            const int rb = unit % (SEQ / 32), hd = (unit / (SEQ / 32)) & 3, b = unit / (4 * (SEQ / 32));
            const size_t r0 = (size_t)b * SEQ + rb * 32;
            for (int idx = tid; idx < 32 * 256; idx += 512) qs[idx] = bf2f(UB[(r0 + (idx >> 8)) * D + hd * 256 + (idx & 255)]);
            __syncthreads();
            const int row = tid >> 4, ks = tid & 15;
            for (int kk = 0; kk < 16; ++kk) {
                const int key = ks + 16 * kk; const bf16* kp = KVM + (size_t)(b * MEML + key) * 2048 + hd * 256;
                float s = 0.f;
                for (int d8 = 0; d8 < 32; ++d8) { const v4u w = *(const GAS v4u*)(kp + d8 * 8); const LAS float* q = qs + row * 256 + d8 * 8;
                    s += q[0] * bflo(w.x) + q[1] * bfhi(w.x) + q[2] * bflo(w.y) + q[3] * bfhi(w.y) + q[4] * bflo(w.z) + q[5] * bfhi(w.z) + q[6] * bflo(w.w) + q[7] * bfhi(w.w); }
                Ss[row * 256 + key] = s;
            }
            __syncthreads();
            { float mx = -1e30f;
              for (int kk = 0; kk < 16; ++kk) mx = fmaxf(mx, Ss[row * 256 + ks + 16 * kk]);
              mx = fmaxf(mx, __shfl_xor(mx, 1)); mx = fmaxf(mx, __shfl_xor(mx, 2)); mx = fmaxf(mx, __shfl_xor(mx, 4)); mx = fmaxf(mx, __shfl_xor(mx, 8));
              float sum = 0.f; float e[16];
#pragma unroll
              for (int kk = 0; kk < 16; ++kk) { e[kk] = __builtin_amdgcn_exp2f(Ss[row * 256 + ks + 16 * kk] - mx); sum += e[kk]; }
              sum += __shfl_xor(sum, 1); sum += __shfl_xor(sum, 2); sum += __shfl_xor(sum, 4); sum += __shfl_xor(sum, 8);
              const float inv = 1.0f / sum;
#pragma unroll
              for (int kk = 0; kk < 16; ++kk) Ss[row * 256 + ks + 16 * kk] = e[kk] * inv; }
            __syncthreads();
            { float o[16];
#pragma unroll
              for (int d = 0; d < 16; ++d) o[d] = 0.f;
              for (int mk = 0; mk < MEML; ++mk) { const float p = Ss[row * 256 + mk]; const bf16* vp = KVM + (size_t)(b * MEML + mk) * 2048 + 1024 + hd * 256 + ks * 16;
                  const v4u v0 = *(const GAS v4u*)vp, v1 = *(const GAS v4u*)(vp + 8);
                  o[0] += p * bflo(v0.x); o[1] += p * bfhi(v0.x); o[2] += p * bflo(v0.y); o[3] += p * bfhi(v0.y); o[4] += p * bflo(v0.z); o[5] += p * bfhi(v0.z); o[6] += p * bflo(v0.w); o[7] += p * bfhi(v0.w);
                  o[8] += p * bflo(v1.x); o[9] += p * bfhi(v1.x); o[10] += p * bflo(v1.y); o[11] += p * bfhi(v1.y); o[12] += p * bflo(v1.z); o[13] += p * bfhi(v1.z); o[14] += p * bflo(v1.w); o[15] += p * bfhi(v1.w); }
              bf16* op = QB + (r0 + row) * D + hd * 256 + ks * 16;
              *(GAS v4u*)op = (v4u){pk2(o[0], o[1]), pk2(o[2], o[3]), pk2(o[4], o[5]), pk2(o[6], o[7])};
              *(GAS v4u*)(op + 8) = (v4u){pk2(o[8], o[9]), pk2(o[10], o[11]), pk2(o[12], o[13]), pk2(o[14], o[15])}; }
            __syncthreads();
        }
#endif
    }
    SEAM(12);
    if (IN(13)) REPEAT(13) {
#if FAST(6)
{ pg8::Gemm g{QB, Wxo, M, D, D}; pg8::StaticOrder S; S.init(M, D, G, bx); pg8::EpiBf16<0> e{KB, D, 1.0f};
        pg8::gemm_phase<pg8::EpiBf16<0>, pg8::StaticOrder, false, true>(lds, g, S, e); }
#else
{ EpiStore e{KB, D, 1.0f}; ngemm(lds, QB, D, Wxo, 1, D, M, D, D, e, vcu, G); }
#endif
    }

    SEAM(13);
    if (IN(14)) REPEAT(14) { const float* g_x_post = INP(29); const float* g_ff_pre = INP(30); for (int m = gw; m < M; m += NGW) resnorm_row(KB + (size_t)m * D, out + (size_t)m * D, g_x_post, out + (size_t)m * D, g_ff_pre, HB + (size_t)m * D, lane); }
    SEAM(14);
    if (IN(15)) REPEAT(15) {
#if FAST(7)
{ pg8::Gemm g{HB, Wf1, M, FF, D}; pg8::StaticOrder S; S.init(M, FF, G, bx); pg8::EpiBf16<2> e{UB, FF, 1.0f};
        pg8::gemm_phase<pg8::EpiBf16<2>, pg8::StaticOrder, true, true>(lds, g, S, e); }
#else
{ EpiRelu2 e{UB, FF}; ngemm(lds, HB, D, Wf1, 1, D, M, FF, D, e, vcu, G); }
#endif
    }

    SEAM(15);
    if (IN(16)) REPEAT(16) {
#if FAST(8)
{ pg8::Gemm g{UB, Wf2, M, D, FF}; pg8::StaticOrder S; S.init(M, D, G, bx); pg8::EpiBf16<0> e{HB, D, 1.0f};
        pg8::gemm_phase<pg8::EpiBf16<0>, pg8::StaticOrder, false, true>(lds, g, S, e); }
#else
{ EpiStore e{HB, D, 1.0f}; ngemm(lds, UB, FF, Wf2, 1, FF, M, D, FF, e, vcu, G); }
#endif
    }

    SEAM(16);
    if (IN(17)) REPEAT(17) { const float* g_ff_post = INP(33); for (int m = gw; m < M; m += NGW) resnorm_row(HB + (size_t)m * D, out + (size_t)m * D, g_ff_post, out + (size_t)m * D, nullptr, nullptr, lane); }
#ifdef SCRIBBLE_TEST
    if (IN(17)) REPEAT(17) { VM_WAIT(); __syncthreads(); if (__hip_atomic_load(ctl + 8, RLX_AGENT) != 0u && bx == 0) { for (int i = tid; i < 4096; i += 512) out[i] = 1000.0f; } }
#endif
#undef IN
#undef SEAM
}

#ifdef RECOMP
__global__ void __launch_bounds__(NWAVES * 64, 2) recomp_kernel(Args args) {
    extern __shared__ __attribute__((aligned(16))) unsigned char lds_raw2[];
    LAS unsigned char* lds = (LAS unsigned char*)lds_raw2;
    const int G = gridDim.x; const int bx = blockIdx.x; const int vcu = (G % 8 == 0) ? (bx % 8) * (G / 8) + bx / 8 : bx;
    unsigned char* ws = args.ws;
    bf16* Win = (bf16*)(ws + WS_WIN); bf16* HB = (bf16*)(ws + WS_H); bf16* UB = (bf16*)(ws + WS_U); bf16* VB = (bf16*)(ws + WS_V); bf16* GT = (bf16*)args.out;
    if (RECOMP & 1) { EpiStore e{UB, D, 1.0f}; ngemm(lds, HB, D, Win, 1, D, M, D, D, e, vcu, G); }
    if (RECOMP & 6) { EpiVG e{VB, GT, args.in[4]}; ngemm(lds, HB, D, Win + (size_t)3072 * D, 1, D, M, 3072, D, e, vcu, G); }
}
#endif
constexpr int N_PHASES = 18;
extern "C" void kernel_launch(void* const* d_in, const int* in_sizes, int n_in, void* d_out, int out_size, void* d_ws, size_t ws_size, hipStream_t stream) {
    static int grid = 0;
    if (grid == 0) {
        if (n_in != 34 || in_sizes[0] != M * D || out_size != M * D || ws_size < WS_END) { fprintf(stderr, "kernel_launch: unexpected shapes (n_in %d, in0 %d, out %d, ws %zu)\n", n_in, n_in > 0 ? in_sizes[0] : -1, out_size, ws_size); grid = -1; return; }
        int dev = 0, cus = 0, per_cu = 0;
        if (hipGetDevice(&dev) != hipSuccess || hipDeviceGetAttribute(&cus, hipDeviceAttributeMultiprocessorCount, dev) != hipSuccess) { grid = -1; return; }
        if (hipFuncSetAttribute((const void*)mk_fwd, hipFuncAttributeMaxDynamicSharedMemorySize, LDS_BYTES) != hipSuccess) { fprintf(stderr, "kernel_launch: hipFuncSetAttribute failed\n"); grid = -1; return; }
        if (hipOccupancyMaxActiveBlocksPerMultiprocessor(&per_cu, (const void*)mk_fwd, NWAVES * 64, LDS_BYTES) != hipSuccess || per_cu < 1) { fprintf(stderr, "kernel_launch: occupancy query says %d\n", per_cu); per_cu = 1; }
        (void)hipGetLastError();
        grid = cus;
    }
    if (grid < 0) return;
    if (hipMemsetAsync((char*)d_ws + WS_CTL, 0, CTL_ZERO_BYTES, stream) != hipSuccess) return;
    Args a{};
    for (int i = 0; i < 34; ++i) a.in[i] = (const float*)d_in[i];
    a.out = (float*)d_out; a.ws = (unsigned char*)d_ws;
    if (MK_N_LAUNCHES == 1) { a.ph_lo = 0; a.ph_hi = N_PHASES; a.li = 0; hipLaunchKernelGGL(mk_fwd, dim3(grid), dim3(NWAVES * 64), LDS_BYTES, stream, a); }
    else { for (int p = 0; p < N_PHASES; ++p) { a.ph_lo = p; a.ph_hi = p + 1; a.li = p; hipLaunchKernelGGL(mk_fwd, dim3(grid), dim3(NWAVES * 64), LDS_BYTES, stream, a);
#ifdef RECOMP
        if (p == 1) { (void)hipFuncSetAttribute((const void*)recomp_kernel, hipFuncAttributeMaxDynamicSharedMemorySize, LDS_BYTES); hipLaunchKernelGGL(recomp_kernel, dim3(grid), dim3(NWAVES * 64), LDS_BYTES, stream, a); }
#endif
    } }
}
```
